# Optimizing an MI355X kernel written in HIP

```python
import math
import numpy as np
import jax
import jax.numpy as jnp
from jax import lax


D_MODEL = 1024
BATCH = 8
SEQ = 2048
DEPTH = 4

D_FF = 2752
HEAD_DIM = 64
HEAD_SLOTS = 16
NUM_BUCKETS = 32
T5_MAX_EXACT = 16
T5_MAX_DIST = 128
Q_BLOCK = 128
GATHER_Q_BLOCK = 32
RMS_EPS = 1e-6
NEG_INF = -1e30
MLA_HEADS = 8
MLA_NOPE = 64
MLA_ROPE = 32
MLA_V = 64
MLA_Q_LORA = 256
MLA_KV_LORA = 128
ROPE_THETA = 10000.0
NSA_HEADS = 8
NSA_GROUPS = 2
NSA_HPG = NSA_HEADS // NSA_GROUPS
NSA_CMP_LEN = 32
NSA_CMP_STRIDE = 16
NSA_CMP_HID = 256
NSA_SLC_BLOCK = 64
NSA_SLC_TOP = 8
NSA_WINDOW = 512
NSA_FORCED = 1e6
DIL_PAIRS = ((128, 1), (512, 4), (2048, 16))
DIL_HPG = 4
DIL_SLOTS = len(DIL_PAIRS) * DIL_HPG
MOBA_HEADS = 4
MOBA_BLOCK = 256
MOBA_TOP = 3
EV_SPLITS = (MLA_Q_LORA, MLA_KV_LORA, MLA_ROPE, NSA_HEADS * HEAD_DIM) + (NSA_GROUPS * HEAD_DIM,) * 6 + (3 * NSA_HEADS,)
EV_COLS = sum(EV_SPLITS)
EV_OUT = MLA_HEADS * MLA_V + NSA_HEADS * HEAD_DIM
OD_SPLITS = (DIL_SLOTS * HEAD_DIM,) * 3 + (MOBA_HEADS * HEAD_DIM,) * 3
OD_COLS = sum(OD_SPLITS)
OD_OUT = DIL_HPG * HEAD_DIM + MOBA_HEADS * HEAD_DIM
N_EVEN = (DEPTH + 1) // 2
N_ODD = DEPTH // 2

kernel_name = 'hybrid_mla_nsa_dilated_moba_macaron'


def split_cols(u, sizes):
    return jnp.split(u, np.cumsum(sizes)[:-1].tolist(), axis=-1)


def rms_norm(x, g):
    x32 = x.astype(jnp.float32)
    y = x32 * lax.rsqrt(jnp.mean(x32 * x32, axis=-1, keepdims=True) + RMS_EPS)
    return (y * g.astype(jnp.float32)).astype(x.dtype)


def masked_softmax(logits, mask):
    l = jnp.where(mask, logits, NEG_INF)
    m = jnp.max(l, axis=-1, keepdims=True)
    e = jnp.where(mask, jnp.exp(l - m), 0.0)
    den = jnp.maximum(jnp.sum(e, axis=-1, keepdims=True), 1e-30)
    return e / den, (m + jnp.log(den))[..., 0]


def t5_bucket(dist):
    n = jnp.maximum(jnp.asarray(dist, jnp.int32), 0)
    nf = jnp.maximum(n, 1).astype(jnp.float32)
    large = T5_MAX_EXACT + (jnp.log(nf / T5_MAX_EXACT) / math.log(T5_MAX_DIST / T5_MAX_EXACT)
                            * (NUM_BUCKETS - T5_MAX_EXACT)).astype(jnp.int32)
    return jnp.where(n < T5_MAX_EXACT, n, jnp.minimum(large, NUM_BUCKETS - 1))


def from_blocks(a):
    n, b, qb = a.shape[:3]
    return jnp.moveaxis(a, 0, 1).reshape(b, n * qb, *a.shape[3:])


def rope_tables(s):
    inv = ROPE_THETA ** (-jnp.arange(0, MLA_ROPE, 2, dtype=jnp.float32) / MLA_ROPE)
    ang = jnp.arange(s, dtype=jnp.float32)[:, None] * inv[None, :]
    return jnp.cos(ang), jnp.sin(ang)


def apply_rope(x, cos, sin):
    x32 = x.astype(jnp.float32)
    half = x.shape[-1] // 2
    x1, x2 = x32[..., :half], x32[..., half:]
    return jnp.concatenate([x1 * cos - x2 * sin, x2 * cos + x1 * sin], axis=-1).astype(x.dtype)


def swiglu(y, w_in, w_out):
    a, b = jnp.split(y @ w_in, 2, axis=-1)
    return (jax.nn.silu(a) * b) @ w_out


def modulate(x, g, shift, scale):
    return rms_norm(x, g) * (1.0 + scale[:, None, :]) + shift[:, None, :]


def causal_dense(q, k, v):
    b, s = q.shape[:2]
    scale = q.shape[-1] ** -0.5
    kpos = jnp.arange(s)

    def block(blk):
        qs = blk * Q_BLOCK
        qb = lax.dynamic_slice_in_dim(q, qs, Q_BLOCK, axis=1)
        qpos = qs + jnp.arange(Q_BLOCK)
        logits = jnp.einsum('bqhd,bkhd->bhqk', qb, k).astype(jnp.float32) * scale
        p, _ = masked_softmax(logits, kpos[None, :] <= qpos[:, None])
        return jnp.einsum('bhqk,bkhd->bqhd', p.astype(v.dtype), v)

    return from_blocks(lax.map(block, jnp.arange(s // Q_BLOCK)))


def band_attn(q, k, v, bias_tab, w, r):
    b, s, g, p_, dh = q.shape
    scale = dh ** -0.5
    nk = w // r + 1
    dist = r * np.arange(nk)
    bias = jnp.transpose(bias_tab[t5_bucket(dist)], (1, 2, 0))[:, :, None, :]
    kp = jnp.pad(k, ((0, 0), (w, 0), (0, 0), (0, 0)))
    vp = jnp.pad(v, ((0, 0), (w, 0), (0, 0), (0, 0)))
    gidx = np.arange(Q_BLOCK)[:, None] + w - dist[None, :]
    dist_j = jnp.asarray(dist)

    def block(blk):
        qs = blk * Q_BLOCK
        qb = lax.dynamic_slice_in_dim(q, qs, Q_BLOCK, axis=1)
        kg = lax.dynamic_slice_in_dim(kp, qs, w + Q_BLOCK, axis=1)[:, gidx]
        vg = lax.dynamic_slice_in_dim(vp, qs, w + Q_BLOCK, axis=1)[:, gidx]
        ok = (qs + jnp.arange(Q_BLOCK)[:, None] - dist_j[None, :]) >= 0
        logits = jnp.einsum('bqgpd,bqkgd->bgpqk', qb, kg).astype(jnp.float32) * scale + bias
        pr, lse = masked_softmax(logits, ok)
        out = jnp.einsum('bgpqk,bqkgd->bqgpd', pr.astype(vg.dtype), vg)
        return out, lse

    outs, lses = lax.map(block, jnp.arange(s // Q_BLOCK))
    lse = jnp.transpose(lses, (1, 0, 4, 2, 3)).reshape(b, s, g, p_)
    return from_blocks(outs), lse


def mla_mixer(cq, ckv, kr, q_norm_g, kv_norm_g, w_uq, w_ukv, qk_g):
    b, s = cq.shape[:2]
    q = (rms_norm(cq, q_norm_g) @ w_uq).reshape(b, s, MLA_HEADS, MLA_NOPE + MLA_ROPE)
    kv = (rms_norm(ckv, kv_norm_g) @ w_ukv).reshape(b, s, MLA_HEADS, MLA_NOPE + MLA_V)
    cos, sin = rope_tables(s)
    q_nope = rms_norm(q[..., :MLA_NOPE], qk_g[0, :MLA_NOPE])
    q_rope = apply_rope(rms_norm(q[..., MLA_NOPE:], qk_g[0, MLA_NOPE:]), cos[:, None, :], sin[:, None, :])
    k_nope = rms_norm(kv[..., :MLA_NOPE], qk_g[1, :MLA_NOPE])
    k_rope = apply_rope(rms_norm(kr, qk_g[1, MLA_NOPE:]), cos, sin)
    qf = jnp.concatenate([q_nope, q_rope], axis=-1)
    kf = jnp.concatenate([k_nope, jnp.broadcast_to(k_rope[:, :, None, :], (b, s, MLA_HEADS, MLA_ROPE))], axis=-1)
    out = causal_dense(qf, kf, kv[..., MLA_NOPE:])
    return out.reshape(b, s, MLA_HEADS * MLA_V)


def nsa_mixer(q, kc, vc, ks, vs, kw, vw, gate_logits, cmp_pe, cmp_w1, cmp_w2, qk_g, bias_tab):
    b, s = q.shape[:2]
    g, p_, dh = NSA_GROUPS, NSA_HPG, HEAD_DIM
    scale = dh ** -0.5
    q = rms_norm(q.reshape(b, s, g, p_, dh), qk_g[0])
    kc, vc, ks, vs, kw, vw = [a.reshape(b, s, g, dh) for a in (kc, vc, ks, vs, kw, vw)]
    ks = rms_norm(ks, qk_g[1])
    kw = rms_norm(kw, qk_g[1])
    t = jnp.arange(s)

    n_cmp = (s - NSA_CMP_LEN) // NSA_CMP_STRIDE + 1
    cstart = np.arange(n_cmp) * NSA_CMP_STRIDE
    cidx = cstart[:, None] + np.arange(NSA_CMP_LEN)[None, :]

    def compress(a, j):
        blk = a[:, cidx] + cmp_pe[j][None, None, :, None, :]
        flat = jnp.moveaxis(blk, 3, 2).reshape(b, n_cmp, g, NSA_CMP_LEN * dh)
        return jax.nn.silu(flat @ cmp_w1[j]) @ cmp_w2[j]

    k_cmp = rms_norm(compress(kc, 0), qk_g[1])
    v_cmp = compress(vc, 1)
    cend = jnp.asarray(cstart + NSA_CMP_LEN - 1)
    mask_c = cend[None, :] <= t[:, None]
    bias_c = jnp.transpose(bias_tab[t5_bucket(t[:, None] - cend[None, :])], (2, 3, 0, 1))
    logits_c = jnp.einsum('bsgpd,bngd->bgpsn', q, k_cmp).astype(jnp.float32) * scale + bias_c
    p_c, _ = masked_softmax(logits_c, mask_c)
    o_c = jnp.einsum('bgpsn,bngd->bsgpd', p_c.astype(v_cmp.dtype), v_cmp)

    n_slc = s // NSA_SLC_BLOCK
    sstart = np.arange(n_slc) * NSA_SLC_BLOCK
    overlap = np.clip(np.minimum(cstart[:, None] + NSA_CMP_LEN, sstart[None, :] + NSA_SLC_BLOCK)
                      - np.maximum(cstart[:, None], sstart[None, :]), 0, None).astype(np.float32) / NSA_CMP_LEN
    imp = jnp.einsum('bgpsn,nm->bgsm', p_c, jnp.asarray(overlap))
    cur = t // NSA_SLC_BLOCK
    ids = jnp.arange(n_slc)[None, :]
    forced = (ids == 0) | (ids == cur[:, None]) | (ids == cur[:, None] - 1)
    score = jnp.where(forced, NSA_FORCED, jnp.where(ids <= cur[:, None], imp, NEG_INF))
    n_sel = min(NSA_SLC_TOP, n_slc)
    top_s, top_i = lax.top_k(score, n_sel)
    sel_ok = top_s > 0.5 * NEG_INF
    k_blk = jnp.transpose(ks.reshape(b, n_slc, NSA_SLC_BLOCK, g, dh), (0, 3, 1, 2, 4))
    v_blk = jnp.transpose(vs.reshape(b, n_slc, NSA_SLC_BLOCK, g, dh), (0, 3, 1, 2, 4))
    bi = jnp.arange(b)[:, None, None, None]
    gi = jnp.arange(g)[None, :, None, None]
    qbn = GATHER_Q_BLOCK

    def sel_block(blk):
        qs = blk * qbn
        qb = lax.dynamic_slice_in_dim(q, qs, qbn, axis=1)
        ib = lax.dynamic_slice_in_dim(top_i, qs, qbn, axis=2)
        okb = lax.dynamic_slice_in_dim(sel_ok, qs, qbn, axis=2)
        kg = k_blk[bi, gi, ib].reshape(b, g, qbn, n_sel * NSA_SLC_BLOCK, dh)
        vg = v_blk[bi, gi, ib].reshape(b, g, qbn, n_sel * NSA_SLC_BLOCK, dh)
        pos = (ib[..., None] * NSA_SLC_BLOCK + jnp.arange(NSA_SLC_BLOCK)).reshape(b, g, qbn, -1)
        dist = (qs + jnp.arange(qbn))[None, None, :, None] - pos
        mask = (jnp.repeat(okb, NSA_SLC_BLOCK, axis=-1) & (dist >= 0))[:, :, None]
        bias = jnp.moveaxis(bias_tab[t5_bucket(dist), gi], -1, 2)
        logits = jnp.einsum('bqgpd,bgqkd->bgpqk', qb, kg).astype(jnp.float32) * scale + bias
        pr, _ = masked_softmax(logits, mask)
        return jnp.einsum('bgpqk,bgqkd->bqgpd', pr.astype(vg.dtype), vg)

    o_s = from_blocks(lax.map(sel_block, jnp.arange(s // qbn)))

    o_w, _ = band_attn(q, kw, vw, bias_tab, NSA_WINDOW - 1, 1)

    gt = jax.nn.sigmoid(gate_logits.astype(jnp.float32)).reshape(b, s, g, p_, 3).astype(q.dtype)
    out = gt[..., 0:1] * o_c + gt[..., 1:2] * o_s + gt[..., 2:3] * o_w
    return out.reshape(b, s, NSA_HEADS * dh)


def dilated_mixer(q, k, v, qk_g, t5_bias):
    b, s = q.shape[:2]
    ng = len(DIL_PAIRS)
    q = rms_norm(q.reshape(b, s, ng, DIL_HPG, HEAD_DIM), qk_g[0])
    k = rms_norm(k.reshape(b, s, ng, DIL_HPG, HEAD_DIM), qk_g[1])
    v = v.reshape(b, s, ng, DIL_HPG, HEAD_DIM)
    outs, lses = [], []
    for gidx, (w, r) in enumerate(DIL_PAIRS):
        tab = t5_bias[:, gidx * DIL_HPG:(gidx + 1) * DIL_HPG][:, :, None]
        o, lse = band_attn(q[:, :, gidx, :, None], k[:, :, gidx], v[:, :, gidx], tab, w, r)
        outs.append(o[:, :, :, 0])
        lses.append(lse[..., 0])
    wts = jax.nn.softmax(jnp.stack(lses), axis=0)
    out = jnp.sum(wts[..., None].astype(q.dtype) * jnp.stack(outs), axis=0)
    return out.reshape(b, s, DIL_HPG * HEAD_DIM)


def moba_mixer(q, k, v, qk_g, bias_tab):
    b, s = q.shape[:2]
    h, dh = MOBA_HEADS, HEAD_DIM
    scale = dh ** -0.5
    q = rms_norm(q.reshape(b, s, h, dh), qk_g[0])
    k = rms_norm(k.reshape(b, s, h, dh), qk_g[1])
    v = v.reshape(b, s, h, dh)
    nb = -(-s // MOBA_BLOCK)
    pad = nb * MOBA_BLOCK - s
    kp = jnp.pad(k, ((0, 0), (0, pad), (0, 0), (0, 0)))
    vp = jnp.pad(v, ((0, 0), (0, pad), (0, 0), (0, 0)))
    k_blk = jnp.transpose(kp.reshape(b, nb, MOBA_BLOCK, h, dh), (0, 3, 1, 2, 4))
    v_blk = jnp.transpose(vp.reshape(b, nb, MOBA_BLOCK, h, dh), (0, 3, 1, 2, 4))
    t = jnp.arange(s)
    own = t // MOBA_BLOCK
    n_top = min(MOBA_TOP, nb - 1)
    if n_top > 0:
        k_mean = jnp.mean(k_blk.astype(jnp.float32), axis=3)
        gate = jnp.einsum('bshd,bhnd->bhsn', q.astype(jnp.float32), k_mean)
        past = jnp.arange(nb)[None, :] < own[:, None]
        top_s, top_i = lax.top_k(jnp.where(past, gate, NEG_INF), n_top)
        sel_ok = top_s > 0.5 * NEG_INF
    bi = jnp.arange(b)[:, None, None, None]
    hi = jnp.arange(h)[None, :, None, None]
    qbn = GATHER_Q_BLOCK

    def block(blk):
        qs = blk * qbn
        qb = lax.dynamic_slice_in_dim(q, qs, qbn, axis=1)
        qpos = qs + jnp.arange(qbn)
        ob = qs // MOBA_BLOCK
        ko = lax.dynamic_slice_in_dim(kp, ob * MOBA_BLOCK, MOBA_BLOCK, axis=1)
        vo = lax.dynamic_slice_in_dim(vp, ob * MOBA_BLOCK, MOBA_BLOCK, axis=1)
        d_own = qpos[:, None] - (ob * MOBA_BLOCK + jnp.arange(MOBA_BLOCK))[None, :]
        logits_own = (jnp.einsum('bqhd,bkhd->bhqk', qb, ko).astype(jnp.float32) * scale
                      + jnp.transpose(bias_tab[t5_bucket(d_own)], (2, 0, 1)))
        mask_own = jnp.broadcast_to(d_own >= 0, logits_own.shape)
        if n_top == 0:
            pr, _ = masked_softmax(logits_own, mask_own)
            return jnp.einsum('bhqk,bkhd->bqhd', pr.astype(vo.dtype), vo)
        ib = lax.dynamic_slice_in_dim(top_i, qs, qbn, axis=2)
        okb = lax.dynamic_slice_in_dim(sel_ok, qs, qbn, axis=2)
        nsel = n_top * MOBA_BLOCK
        kg = k_blk[bi, hi, ib].reshape(b, h, qbn, nsel, dh)
        vg = v_blk[bi, hi, ib].reshape(b, h, qbn, nsel, dh)
        pos = (ib[..., None] * MOBA_BLOCK + jnp.arange(MOBA_BLOCK)).reshape(b, h, qbn, nsel)
        logits_sel = (jnp.einsum('bqhd,bhqkd->bhqk', qb, kg).astype(jnp.float32) * scale
                      + bias_tab[t5_bucket(qpos[None, None, :, None] - pos), hi])
        mask_sel = jnp.repeat(okb, MOBA_BLOCK, axis=-1)
        pr, _ = masked_softmax(jnp.concatenate([logits_sel, logits_own], axis=-1),
                               jnp.concatenate([mask_sel, mask_own], axis=-1))
        pr = pr.astype(v.dtype)
        return (jnp.einsum('bhqk,bhqkd->bqhd', pr[..., :nsel], vg)
                + jnp.einsum('bhqk,bkhd->bqhd', pr[..., nsel:], vo))

    return from_blocks(lax.map(block, jnp.arange(s // qbn))).reshape(b, s, h * dh)


def even_mixer(y, w_in, w_out, q_norm_g, kv_norm_g, w_uq, w_ukv, mla_qk_g, cmp_pe, cmp_w1, cmp_w2, nsa_qk_g, t5_bias):
    cq, ckv, kr, qn, kc, vc, ks, vs, kw, vw, gl = split_cols(y @ w_in, EV_SPLITS)
    o_a = mla_mixer(cq, ckv, kr, q_norm_g, kv_norm_g, w_uq, w_ukv, mla_qk_g)
    tab = t5_bias[:, MLA_HEADS:MLA_HEADS + NSA_HEADS].reshape(NUM_BUCKETS, NSA_GROUPS, NSA_HPG)
    o_b = nsa_mixer(qn, kc, vc, ks, vs, kw, vw, gl, cmp_pe, cmp_w1, cmp_w2, nsa_qk_g, tab)
    return jnp.concatenate([o_a, o_b], axis=-1) @ w_out


def odd_mixer(y, w_in, w_out, dil_qk_g, moba_qk_g, t5_bias):
    qd, kd, vd, qm, km, vm = split_cols(y @ w_in, OD_SPLITS)
    o_c = dilated_mixer(qd, kd, vd, dil_qk_g, t5_bias)
    o_d = moba_mixer(qm, km, vm, moba_qk_g, t5_bias[:, DIL_SLOTS:DIL_SLOTS + MOBA_HEADS])
    return jnp.concatenate([o_c, o_d], axis=-1) @ w_out


def setup_inputs(seed: int = 0) -> dict:
    key = jax.random.key(seed)
    keys = iter(jax.random.split(key, 32))

    def nrm(shape, scale):
        return jax.random.normal(next(keys), shape, jnp.float32) * scale

    return {
        'x': nrm((BATCH, SEQ, D_MODEL), 1.0),
        'c': nrm((BATCH, D_MODEL), 1.0),
        't5_bias': nrm((NUM_BUCKETS, HEAD_SLOTS), 0.5),
        'ada_w': nrm((DEPTH, D_MODEL, 9 * D_MODEL), D_MODEL ** -0.5),
        'ada_b': nrm((DEPTH, 9 * D_MODEL), 0.02),
        'norm_g': 1.0 + nrm((DEPTH, 3, D_MODEL), 0.05),
        'ffn_w_in': nrm((DEPTH, 2, D_MODEL, 2 * D_FF), D_MODEL ** -0.5),
        'ffn_w_out': nrm((DEPTH, 2, D_FF, D_MODEL), D_FF ** -0.5),
        'ev_w_in': nrm((N_EVEN, D_MODEL, EV_COLS), D_MODEL ** -0.5),
        'ev_w_out': nrm((N_EVEN, EV_OUT, D_MODEL), EV_OUT ** -0.5),
        'mla_q_norm_g': 1.0 + nrm((N_EVEN, MLA_Q_LORA), 0.05),
        'mla_kv_norm_g': 1.0 + nrm((N_EVEN, MLA_KV_LORA), 0.05),
        'mla_w_uq': nrm((N_EVEN, MLA_Q_LORA, MLA_HEADS * (MLA_NOPE + MLA_ROPE)), MLA_Q_LORA ** -0.5),
        'mla_w_ukv': nrm((N_EVEN, MLA_KV_LORA, MLA_HEADS * (MLA_NOPE + MLA_V)), MLA_KV_LORA ** -0.5),
        'mla_qk_g': 1.0 + nrm((N_EVEN, 2, MLA_NOPE + MLA_ROPE), 0.05),
        'nsa_cmp_pe': nrm((N_EVEN, 2, NSA_CMP_LEN, HEAD_DIM), 0.1),
        'nsa_cmp_w1': nrm((N_EVEN, 2, NSA_CMP_LEN * HEAD_DIM, NSA_CMP_HID), (NSA_CMP_LEN * HEAD_DIM) ** -0.5),
        'nsa_cmp_w2': nrm((N_EVEN, 2, NSA_CMP_HID, HEAD_DIM), NSA_CMP_HID ** -0.5),
        'nsa_qk_g': 1.0 + nrm((N_EVEN, 2, HEAD_DIM), 0.05),
        'od_w_in': nrm((N_ODD, D_MODEL, OD_COLS), D_MODEL ** -0.5),
        'od_w_out': nrm((N_ODD, OD_OUT, D_MODEL), OD_OUT ** -0.5),
        'dil_qk_g': 1.0 + nrm((N_ODD, 2, HEAD_DIM), 0.05),
        'moba_qk_g': 1.0 + nrm((N_ODD, 2, HEAD_DIM), 0.05),
    }


def reference(x, c, t5_bias, ada_w, ada_b, norm_g, ffn_w_in, ffn_w_out, ev_w_in, ev_w_out,
              mla_q_norm_g, mla_kv_norm_g, mla_w_uq, mla_w_ukv, mla_qk_g, nsa_cmp_pe, nsa_cmp_w1,
              nsa_cmp_w2, nsa_qk_g, od_w_in, od_w_out, dil_qk_g, moba_qk_g):
    b, d = x.shape[0], x.shape[-1]
    c_act = jax.nn.silu(c)
    for i in range(DEPTH):
        mod = (c_act @ ada_w[i] + ada_b[i]).reshape(b, 3, 3, d)
        y = modulate(x, norm_g[i, 0], mod[:, 0, 0], mod[:, 0, 1])
        x = x + 0.5 * mod[:, 0, 2][:, None, :] * swiglu(y, ffn_w_in[i, 0], ffn_w_out[i, 0])
        y = modulate(x, norm_g[i, 1], mod[:, 1, 0], mod[:, 1, 1])
        j = i // 2
        if i % 2 == 0:
            m = even_mixer(y, ev_w_in[j], ev_w_out[j], mla_q_norm_g[j], mla_kv_norm_g[j], mla_w_uq[j],
                           mla_w_ukv[j], mla_qk_g[j], nsa_cmp_pe[j], nsa_cmp_w1[j], nsa_cmp_w2[j],
                           nsa_qk_g[j], t5_bias)
        else:
            m = odd_mixer(y, od_w_in[j], od_w_out[j], dil_qk_g[j], moba_qk_g[j], t5_bias)
        x = x + mod[:, 1, 2][:, None, :] * m
        y = modulate(x, norm_g[i, 2], mod[:, 2, 0], mod[:, 2, 1])
        x = x + 0.5 * mod[:, 2, 2][:, None, :] * swiglu(y, ffn_w_in[i, 1], ffn_w_out[i, 1])
    return x
```

```cpp
#include <hip/hip_runtime.h>
#include <hip/hip_cooperative_groups.h>
#include <cstdio>
#include <cstdint>
namespace cg = cooperative_groups;

#define DI __device__ __forceinline__
#define LAS __attribute__((address_space(3)))
typedef unsigned short bf16_t;
typedef short bf16x8 __attribute__((ext_vector_type(8)));
typedef short s16x4 __attribute__((ext_vector_type(4)));
typedef short v4i16_t __attribute__((ext_vector_type(4)));
typedef float f32x4 __attribute__((ext_vector_type(4)));
typedef float f32x16 __attribute__((ext_vector_type(16)));
typedef unsigned u32x4 __attribute__((ext_vector_type(4)));
typedef unsigned u32x2 __attribute__((ext_vector_type(2)));
typedef float f32x2_t __attribute__((ext_vector_type(2)));
typedef __bf16 bf16x2_t __attribute__((ext_vector_type(2)));

constexpr int D = 1024, NB = 8, S = 2048, M = NB * S, DEPTH = 4, DFF = 2752, DFFP = 2816, NFF = 5632;
constexpr int EVC = 1720, EVCP = 1792, ODC = 3072;
constexpr float EPS = 1e-6f;
constexpr float L2E = 1.44269504088896f;

constexpr size_t MiB = 1u << 20;
constexpr size_t WS_CTL = 0, CTL_BYTES = 64 * 1024;
constexpr size_t WS_MOD = 1 * MiB;
constexpr size_t WS_ROPE = 3 * MiB;
constexpr size_t WS_LUT = 3 * MiB + 512 * 1024;
constexpr size_t WS_KMEAN = 3 * MiB + 768 * 1024;
constexpr size_t WS_WFI = 4 * MiB;
constexpr size_t WS_WFO = 92 * MiB;
constexpr size_t WS_WEI = 136 * MiB;
constexpr size_t WS_WEO = 143 * MiB;
constexpr size_t WS_WUQ = 147 * MiB;
constexpr size_t WS_WUKV = 148 * MiB;
constexpr size_t WS_WC1 = 149 * MiB;
constexpr size_t WS_WOI = 153 * MiB;
constexpr size_t WS_WOO = 165 * MiB;
constexpr size_t WS_Y = 168 * MiB;
constexpr size_t WS_H = 200 * MiB;
constexpr size_t WS_U = 288 * MiB;
constexpr size_t WS_CAT = 384 * MiB;
constexpr size_t WS_CQN = 416 * MiB;
constexpr size_t WS_CKVN = 424 * MiB;
constexpr size_t WS_KROPE = 428 * MiB;
constexpr size_t WS_NQ = 429 * MiB;
constexpr size_t WS_NKS = 445 * MiB;
constexpr size_t WS_NKW = 449 * MiB;
constexpr size_t WS_GT = 453 * MiB;
constexpr size_t WS_ACMP = 455 * MiB;
constexpr size_t WS_HID = 471 * MiB;
constexpr size_t WS_KCMP = 473 * MiB;
constexpr size_t WS_VCMP = 473 * MiB + 512 * 1024;
constexpr size_t WS_QFULL = 474 * MiB;
constexpr size_t WS_KVFULL = 498 * MiB;
constexpr size_t WS_QF = 530 * MiB;
constexpr size_t WS_KF = 554 * MiB;
constexpr size_t WS_NRM = 416 * MiB;
constexpr size_t WS_END = 578 * MiB;

constexpr int LDS_BYTES = 147456;

DI unsigned f2bf(float f) { unsigned u = __builtin_bit_cast(unsigned, f); return (u + 0x7fffu + ((u >> 16) & 1u)) >> 16; }
DI unsigned pk2(float lo, float hi) { f32x2_t v = {lo, hi}; bf16x2_t b = __builtin_convertvector(v, bf16x2_t); return __builtin_bit_cast(unsigned, b); }
DI float bflo(unsigned w) { return __builtin_bit_cast(float, w << 16); }
DI float bfhi(unsigned w) { return __builtin_bit_cast(float, w & 0xffff0000u); }
DI float bf1(bf16_t b) { return __builtin_bit_cast(float, ((unsigned)b) << 16); }
DI float shx(float v, int mask) {
    int t = threadIdx.x; asm volatile("" : "+v"(t));
    return __builtin_bit_cast(float, __builtin_amdgcn_ds_bpermute(((t & 63) ^ mask) << 2, __builtin_bit_cast(int, v)));
}
DI float wave_sum(float v) {
#pragma unroll
    for (int o = 1; o < 64; o <<= 1) v += shx(v, o);
    return v;
}
DI float fsilu(float a) { return a / (1.f + __expf(-a)); }

namespace pg8 {
constexpr int BM = 256, BK = 64, HALF = 128, HTB = HALF * BK * 2, STAGE_BYTES = 8 * HTB, NXCD = 8, WGM = 8;
DI int lds_byte(int r, int c) { const int st = (r >> 4) * 2 + (c >> 5), rr = r & 15, cc = c & 31, ob = rr * 64 + cc * 2; return st * 1024 + (ob ^ (((ob >> 9) & 1) << 5)); }
DI void stage_rc(int b, int& R, int& C) { const int st = b / 1024, sb = b % 1024, swz = sb ^ (((sb >> 9) & 1) << 5); R = (st >> 1) * 16 + swz / 64; C = (st & 1) * 32 + (swz % 64) / 2; }
DI int perm32(int rho) { const int n = rho >> 4, i = rho & 15; return 8 * (i >> 2) + 4 * n + (i & 3); }
struct Unit { int pm, pn; };
struct Gemm { const bf16_t* A; const bf16_t* Bt; int M, N, K; };
struct StaticOrder {
    int nM, nN, nwg, G, c;
    DI void init(int M_, int N_, int G_, int c_) { nM = M_ / BM; nN = N_ / BM; nwg = nM * nN; G = G_; c = c_; }
    DI bool next(int i, Unit& u) const {
        const long L = (long)i * G + c; if (L >= nwg) return false;
        int wgid = (int)L; { const int q = nwg / NXCD, r = nwg % NXCD, xcd = wgid % NXCD, off = wgid / NXCD; wgid = (xcd < r ? xcd * (q + 1) : r * (q + 1) + (xcd - r) * q) + off; }
        const int nig = WGM * nN, gid = wgid / nig, fm = gid * WGM, gsz = (nM - fm) < WGM ? (nM - fm) : WGM;
        u.pm = fm + ((wgid % nig) % gsz); u.pn = (wgid % nig) / gsz; return true;
    }
    DI void a_ready(const Unit&) const {}
    DI void done(const Unit&) const {}
};

struct EpiBf16 {
    static constexpr bool PERM = true, AFTER_DRAIN = false;
    bf16_t* O; int ldc; int act;
    DI void operator()(const f32x4 (&acc)[2][2][4][2], const Unit& u, int wr, int wc, int fr, int fq) const {
        const int row0 = u.pm * BM + wr * 64 + fr, col0 = u.pn * BM + wc * 32 + 8 * fq;
#pragma unroll
        for (int ai = 0; ai < 2; ++ai)
#pragma unroll
            for (int m = 0; m < 4; ++m) { bf16_t* rowp = O + (size_t)(row0 + ai * HALF + m * 16) * ldc + col0;
#pragma unroll
                for (int bj = 0; bj < 2; ++bj) { f32x4 v0 = acc[ai][bj][m][0], v1 = acc[ai][bj][m][1];
                    if (act) { for (int e = 0; e < 4; ++e) { v0[e] = fsilu(v0[e]); v1[e] = fsilu(v1[e]); } }
                    u32x4 w; w.x = pk2(v0[0], v0[1]); w.y = pk2(v0[2], v0[3]); w.z = pk2(v1[0], v1[1]); w.w = pk2(v1[2], v1[3]);
                    *(u32x4*)(rowp + bj * HALF) = w; } }
    }
};
struct EpiSwiglu {
    static constexpr bool PERM = true, AFTER_DRAIN = false;
    bf16_t* H; int ldc;
    DI void operator()(const f32x4 (&acc)[2][2][4][2], const Unit& u, int wr, int wc, int fr, int fq) const {
        const int row0 = u.pm * BM + wr * 64 + fr, col0 = u.pn * HALF + wc * 32 + 8 * fq;
#pragma unroll
        for (int ai = 0; ai < 2; ++ai)
#pragma unroll
            for (int m = 0; m < 4; ++m) { bf16_t* rowp = H + (size_t)(row0 + ai * HALF + m * 16) * ldc + col0;
                f32x4 a0 = acc[ai][0][m][0], a1 = acc[ai][0][m][1], b0 = acc[ai][1][m][0], b1 = acc[ai][1][m][1];
#pragma unroll
                for (int e = 0; e < 4; ++e) { a0[e] = fsilu(a0[e]) * b0[e]; a1[e] = fsilu(a1[e]) * b1[e]; }
                u32x4 w; w.x = pk2(a0[0], a0[1]); w.y = pk2(a0[2], a0[3]); w.z = pk2(a1[0], a1[1]); w.w = pk2(a1[2], a1[3]);
                *(u32x4*)rowp = w; }
    }
};
struct EpiResid {
    static constexpr bool PERM = false, AFTER_DRAIN = false;
    const float* xin; float* xout; const float* gate; float gmul;
    DI void operator()(const f32x4 (&acc)[2][2][4][2], const Unit& u, int wr, int wc, int fr, int fq) const {
        const int row0 = u.pm * BM + wr * 64 + fr, col0 = u.pn * BM + wc * 32 + 4 * fq;
        const float* g = gate + (size_t)(u.pm >> 3) * 9216;
#pragma unroll
        for (int bj = 0; bj < 2; ++bj)
#pragma unroll
            for (int n = 0; n < 2; ++n) { const f32x4 gv = *(const f32x4*)(g + col0 + bj * HALF + n * 16) * gmul;
#pragma unroll
                for (int ai = 0; ai < 2; ++ai)
#pragma unroll
                    for (int m = 0; m < 4; ++m) { const size_t off = (size_t)(row0 + ai * HALF + m * 16) * D + col0 + bj * HALF + n * 16;
                        const f32x4 xi = *(const f32x4*)(xin + off); *(f32x4*)(xout + off) = xi + gv * acc[ai][bj][m][n]; } }
    }
};

template <class Epi, class Sched, bool ALIGN_EPI = false>
DI void gemm_phase(LAS unsigned char* lds, const Gemm g, const Sched& S_, const Epi& E) {
    int tid = threadIdx.x; asm volatile("" : "+v"(tid));
    const int wid = __builtin_amdgcn_readfirstlane(tid >> 6), lane = tid & 63, wr = wid >> 2, wc = wid & 3, fr = lane & 15, fq = lane >> 4;
    const int K = g.K, nt = K / BK;
    unsigned voffA[2], voffB[2];
#pragma unroll
    for (int i = 0; i < 2; ++i) { int R, C; stage_rc(tid * 16 + i * 8192, R, C); const int Rb = Epi::PERM ? ((R & ~31) + perm32(R & 31)) : R;
        voffA[i] = (unsigned)(R * K + C) * 2u; voffB[i] = (unsigned)(Rb * K + C) * 2u; }
    const size_t kstep = (size_t)(BK * 2);
    const size_t hstep = (size_t)HALF * K * 2;
    const size_t tstep = 2 * hstep;
    const unsigned ldsw = (unsigned)wid * 1024u;
    const int aoff = lds_byte(wr * 64 + fr, fq * 8), boff = lds_byte(wc * 32 + fr, fq * 8);
#define PG8_SA(b, h) (((b) * 2 + (h)) * HTB)
#define PG8_SB(b, h) ((4 + (b) * 2 + (h)) * HTB)
#define PG8_STAGE(bufoff, gbase, voff) do { _Pragma("unroll") for (int _i = 0; _i < 2; ++_i) \
        __builtin_amdgcn_global_load_lds((const unsigned*)((const char*)(gbase) + (voff)[_i]), (LAS unsigned*)(lds + (bufoff) + ldsw + _i * 8192), 16, 0, 0); } while (0)
#define PG8_LDA(dst, b, h) do { _Pragma("unroll") for (int m = 0; m < 4; ++m) _Pragma("unroll") for (int k = 0; k < 2; ++k) dst[m][k] = *(const LAS bf16x8*)(lds + PG8_SA(b, h) + aoff + m * 2048 + k * 1024); } while (0)
#define PG8_LDB(dst, b, h) do { _Pragma("unroll") for (int n = 0; n < 2; ++n) _Pragma("unroll") for (int k = 0; k < 2; ++k) dst[n][k] = *(const LAS bf16x8*)(lds + PG8_SB(b, h) + boff + n * 2048 + k * 1024); } while (0)
#define PG8_MMA(ai, bj, At, Bt) do { __builtin_amdgcn_s_setprio(1); _Pragma("unroll") for (int m = 0; m < 4; ++m) _Pragma("unroll") for (int n = 0; n < 2; ++n) _Pragma("unroll") for (int k = 0; k < 2; ++k) \
        acc[ai][bj][m][n] = __builtin_amdgcn_mfma_f32_16x16x32_bf16(Bt[n][k], At[m][k], acc[ai][bj][m][n], 0, 0, 0); __builtin_amdgcn_s_setprio(0); } while (0)
#define PG8_WAIT_V(n) asm volatile("s_waitcnt vmcnt(" #n ")" ::: "memory")
#define PG8_WAIT_L(n) asm volatile("s_waitcnt lgkmcnt(" #n ")" ::: "memory")
#define PG8_BAR __builtin_amdgcn_s_barrier()
#define PG8_SCHED __builtin_amdgcn_sched_barrier(0)
    Unit cur, nxt; int ui = 0;
    if (!S_.next(0, cur)) return;
    f32x4 acc[2][2][4][2];
#pragma unroll
    for (int a = 0; a < 2; ++a)
#pragma unroll
        for (int b = 0; b < 2; ++b)
#pragma unroll
            for (int m = 0; m < 4; ++m)
#pragma unroll
                for (int n = 0; n < 2; ++n) acc[a][b][m][n] = (f32x4){0.f, 0.f, 0.f, 0.f};
    bf16x8 At[4][2], B0[2][2], B1[2][2];
    const char* cA = (const char*)g.A + (size_t)cur.pm * tstep; const char* cB = (const char*)g.Bt + (size_t)cur.pn * tstep;
    PG8_STAGE(PG8_SB(0, 0), cB, voffB); PG8_STAGE(PG8_SB(0, 1), cB + hstep, voffB); PG8_STAGE(PG8_SA(0, 0), cA, voffA); PG8_STAGE(PG8_SA(0, 1), cA + hstep, voffA);
    if (wr == 1) PG8_BAR;
    PG8_WAIT_V(2); PG8_BAR;
    PG8_STAGE(PG8_SB(1, 0), cB + kstep, voffB); PG8_STAGE(PG8_SA(1, 0), cA + kstep, voffA); PG8_STAGE(PG8_SB(1, 1), cB + hstep + kstep, voffB);
    PG8_WAIT_V(6); PG8_BAR;
    for (;;) {
        const bool has_next = S_.next(ui + 1, nxt);
        const char* nA = has_next ? (const char*)g.A + (size_t)nxt.pm * tstep : cA; const char* nB = has_next ? (const char*)g.Bt + (size_t)nxt.pn * tstep : cB;
        for (int t = 0; t < nt; t += 2) {
            const bool last = (t == nt - 2);
            const char* a1 = cA + (size_t)(t + 1) * kstep;
            const char* a2 = last ? nA : cA + (size_t)(t + 2) * kstep; const char* b2 = last ? nB : cB + (size_t)(t + 2) * kstep;
            const char* a3 = a2 + kstep; const char* b3 = b2 + kstep;
            PG8_LDB(B0, 0, 0); PG8_LDB(B1, 0, 1); PG8_SCHED; PG8_LDA(At, 0, 0); PG8_STAGE(PG8_SA(1, 1), a1 + hstep, voffA);
            PG8_WAIT_V(8); PG8_WAIT_L(0); PG8_BAR; PG8_MMA(0, 0, At, B0); PG8_MMA(0, 1, At, B1); PG8_BAR; PG8_SCHED;
            PG8_LDA(At, 0, 1); PG8_STAGE(PG8_SB(0, 0), b2, voffB); PG8_STAGE(PG8_SB(0, 1), b2 + hstep, voffB); PG8_STAGE(PG8_SA(0, 0), a2, voffA);
            PG8_WAIT_V(8); PG8_WAIT_L(0); PG8_BAR; PG8_MMA(1, 0, At, B0); PG8_MMA(1, 1, At, B1); PG8_BAR; PG8_SCHED;
            PG8_LDB(B0, 1, 0); PG8_LDB(B1, 1, 1); PG8_SCHED; PG8_LDA(At, 1, 0); PG8_STAGE(PG8_SA(0, 1), a2 + hstep, voffA);
            PG8_WAIT_V(8); PG8_WAIT_L(0); PG8_BAR; PG8_MMA(0, 0, At, B0); PG8_MMA(0, 1, At, B1); PG8_BAR; PG8_SCHED;
            PG8_LDA(At, 1, 1); PG8_STAGE(PG8_SB(1, 0), b3, voffB); PG8_STAGE(PG8_SB(1, 1), b3 + hstep, voffB); PG8_STAGE(PG8_SA(1, 0), a3, voffA);
            PG8_WAIT_V(8); PG8_WAIT_L(0); PG8_BAR; PG8_MMA(1, 0, At, B0); PG8_MMA(1, 1, At, B1); PG8_BAR; PG8_SCHED;
        }
        if constexpr (ALIGN_EPI) { if (wr == 0) PG8_BAR; }
        E(acc, cur, wr, wc, fr, fq);
        if (!has_next) break;
#pragma unroll
        for (int a = 0; a < 2; ++a)
#pragma unroll
            for (int b = 0; b < 2; ++b)
#pragma unroll
                for (int m = 0; m < 4; ++m)
#pragma unroll
                    for (int n = 0; n < 2; ++n) acc[a][b][m][n] = (f32x4){0.f, 0.f, 0.f, 0.f};
        cur = nxt; cA = nA; cB = nB; ++ui;
        if constexpr (ALIGN_EPI) { if (wr == 1) PG8_BAR; }
    }
    PG8_WAIT_V(0);
    if constexpr (!ALIGN_EPI) { if (wr == 0) PG8_BAR; }
    PG8_BAR;
#undef PG8_SA
#undef PG8_SB
#undef PG8_STAGE
#undef PG8_LDA
#undef PG8_LDB
#undef PG8_MMA
#undef PG8_WAIT_V
#undef PG8_WAIT_L
#undef PG8_BAR
#undef PG8_SCHED
}
}

constexpr int WL_BYTES = 18432, WL_LUT = 0, WL_K = 640, WL_IMP = 9856, VROWB = 144;
DI int crow(int i, int h) { return (i & 3) + 8 * (i >> 2) + 4 * h; }
DI s16x4 vtr(const LAS char* p) { return __builtin_bit_cast(s16x4, __builtin_amdgcn_ds_read_tr16_b64_v4i16((LAS v4i16_t*)p)); }
#define MFMA32(a, b, c) __builtin_amdgcn_mfma_f32_32x32x16_bf16((a), (b), (c), 0, 0, 0)

template <int DK> struct KVRegs { u32x4 k[DK / 16]; u32x4 v[4]; };

template <int DK>
DI void kv_load(KVRegs<DK>& R, const bf16_t* __restrict__ Kb, int kstride, const bf16_t* __restrict__ Vb, int vstride, int krow0, int krstep, int i0, int nkeys, int lane) {
    constexpr int CPR = DK / 8;
#pragma unroll
    for (int c = 0; c < DK / 16; ++c) { const int ch = c * 64 + lane, row = ch / CPR, cc = ch % CPR; int idx = i0 + row; idx = idx < nkeys ? idx : nkeys - 1;
        R.k[c] = *(const u32x4*)(Kb + (size_t)(krow0 + krstep * idx) * kstride + cc * 8); }
    if (Vb) {
#pragma unroll
        for (int c = 0; c < 4; ++c) { const int ch = c * 64 + lane, row = ch >> 3, cc = ch & 7; int idx = i0 + row; idx = idx < nkeys ? idx : nkeys - 1;
            R.v[c] = *(const u32x4*)(Vb + (size_t)(krow0 + krstep * idx) * vstride + cc * 8); }
    }
}
template <int DK>
DI void kv_stage(const KVRegs<DK>& R, LAS char* wl, bool hasv, int lane) {
    constexpr int CPR = DK / 8, KROWB = DK * 2 + 16;
#pragma unroll
    for (int c = 0; c < DK / 16; ++c) { const int ch = c * 64 + lane, row = ch / CPR, cc = ch % CPR; *(LAS u32x4*)(wl + WL_K + row * KROWB + cc * 16) = R.k[c]; }
    if (hasv) {
#pragma unroll
        for (int c = 0; c < 4; ++c) { const int ch = c * 64 + lane, row = ch >> 3, cc = ch & 7; *(LAS u32x4*)(wl + WL_K + 32 * KROWB + row * VROWB + cc * 16) = R.v[c]; }
    }
}
template <int DK>
DI void qk_tile(f32x16& Sx, const LAS char* wl, const bf16x8 (&qf)[DK / 16], int i0, int nkeys, int kpos0, int kpstep, int qpos, int W,
                unsigned selmask, int blkshift, bool usesel, bool uselut, float sc, int lane) {
    constexpr int KROWB = DK * 2 + 16;
    const int r = lane & 31, h = lane >> 5;
#pragma unroll
    for (int i = 0; i < 16; ++i) Sx[i] = 0.f;
#pragma unroll
    for (int ks = 0; ks < DK / 16; ++ks) { const bf16x8 kf = *(const LAS bf16x8*)(wl + WL_K + r * KROWB + ks * 32 + h * 16); Sx = MFMA32(kf, qf[ks], Sx); }
    const LAS float* lut = (const LAS float*)(wl + WL_LUT);
#pragma unroll
    for (int i = 0; i < 16; ++i) {
        const int idx = i0 + crow(i, h), kpos = kpos0 + kpstep * idx, dist = qpos - kpos;
        bool valid = (idx < nkeys) && (dist >= 0) && (dist <= W);
        if (usesel) valid = valid && ((selmask >> ((kpos >> blkshift) & 31)) & 1u);
        float bias = 0.f;
        if (uselut) { int di = dist < 0 ? 0 : (dist > 128 ? 128 : dist); bias = lut[di]; }
        Sx[i] = valid ? Sx[i] * sc + bias : -1e30f;
    }
}

template <int DK>
DI void attn_core(LAS char* wl, const bf16x8 (&qf)[DK / 16], const bf16_t* __restrict__ Kb, int kstride, const bf16_t* __restrict__ Vb, int vstride,
                  int krow0, int krstep, int kpos0, int kpstep, int i_lo, int i_hi, int nkeys, int qpos, int W,
                  unsigned selmask, int blkshift, bool usesel, bool uselut, float sc, f32x16 (&O)[2], float& m, float& l, int lane_in) {
    int lane = lane_in; asm volatile("" : "+v"(lane));
    const int h = lane >> 5;
#define ATT_ADV(iv) while ((iv) < i_hi && usesel && __ballot(((selmask >> (((kpos0 + kpstep * (iv)) >> blkshift) & 31)) & 1u) != 0) == 0ull) (iv) += 32;
    int i0 = i_lo; ATT_ADV(i0);
    if (i0 >= i_hi) return;
    KVRegs<DK> R;
    kv_load<DK>(R, Kb, kstride, Vb, vstride, krow0, krstep, i0, nkeys, lane);
    const int q4 = (lane & 15) >> 2, p4 = lane & 3, blk = (lane >> 4) & 1;
    const LAS char* vbase = wl + WL_K + 32 * (DK * 2 + 16) + (4 * h + q4) * VROWB + blk * 32 + p4 * 8;
    for (;;) {
        kv_stage<DK>(R, wl, true, lane);
        int inext = i0 + 32; ATT_ADV(inext);
        if (inext < i_hi) kv_load<DK>(R, Kb, kstride, Vb, vstride, krow0, krstep, inext, nkeys, lane);
        f32x16 Sx;
        qk_tile<DK>(Sx, wl, qf, i0, nkeys, kpos0, kpstep, qpos, W, selmask, blkshift, usesel, uselut, sc, lane);
        float tmax = Sx[0];
#pragma unroll
        for (int i = 1; i < 16; ++i) tmax = fmaxf(tmax, Sx[i]);
        tmax = fmaxf(tmax, shx(tmax, 32));
        const float mnew = fmaxf(m, tmax), alpha = __builtin_amdgcn_exp2f(m - mnew);
        m = mnew;
        float psum = 0.f;
#pragma unroll
        for (int i = 0; i < 16; ++i) { const float p = Sx[i] > -5e29f ? __builtin_amdgcn_exp2f(Sx[i] - mnew) : 0.f; Sx[i] = p; psum += p; }
        l = l * alpha + psum;
#pragma unroll
        for (int i = 0; i < 16; ++i) { O[0][i] *= alpha; O[1][i] *= alpha; }
#pragma unroll
        for (int s = 0; s < 2; ++s) {
            u32x4 pw; pw.x = pk2(Sx[8 * s], Sx[8 * s + 1]); pw.y = pk2(Sx[8 * s + 2], Sx[8 * s + 3]); pw.z = pk2(Sx[8 * s + 4], Sx[8 * s + 5]); pw.w = pk2(Sx[8 * s + 6], Sx[8 * s + 7]);
            const bf16x8 pb = __builtin_bit_cast(bf16x8, pw);
#pragma unroll
            for (int db = 0; db < 2; ++db) {
                const s16x4 lo = vtr(vbase + (16 * s) * VROWB + db * 64), hi = vtr(vbase + (16 * s + 8) * VROWB + db * 64);
                const bf16x8 va = __builtin_shufflevector(lo, hi, 0, 1, 2, 3, 4, 5, 6, 7);
                O[db] = MFMA32(va, pb, O[db]);
            }
        }
        if (inext >= i_hi) break;
        i0 = inext;
    }
#undef ATT_ADV
}
DI void o_zero(f32x16 (&O)[2]) {
#pragma unroll
    for (int i = 0; i < 16; ++i) { O[0][i] = 0.f; O[1][i] = 0.f; }
}
DI void o_store(bf16_t* outp, const f32x16 (&O)[2], float scale, int h) {
#pragma unroll
    for (int db = 0; db < 2; ++db)
#pragma unroll
        for (int g4 = 0; g4 < 4; ++g4) { u32x2 w; w.x = pk2(O[db][4 * g4] * scale, O[db][4 * g4 + 1] * scale); w.y = pk2(O[db][4 * g4 + 2] * scale, O[db][4 * g4 + 3] * scale);
            *(u32x2*)(outp + 32 * db + 8 * g4 + 4 * h) = w; }
}
DI void lut_write(LAS char* wl, const float* lutg, int slot, int lane) {
    LAS float* lut = (LAS float*)(wl + WL_LUT);
    for (int i = lane; i < 132; i += 64) lut[i] = lutg[slot * 132 + i];
}
template <int NQ>
DI void q_load(bf16x8 (&qf)[NQ], const bf16_t* qrow, int h) {
#pragma unroll
    for (int ks = 0; ks < NQ; ++ks) qf[ks] = *(const bf16x8*)(qrow + ks * 16 + h * 8);
}

struct Args {
    const float* in[23]; float* out; unsigned char* ws; int ph_lo, ph_hi;
};

struct Ctx {
    const float* const* in; float* out; unsigned char* ws; LAS unsigned char* lds;
    int tid, lane, wave, gw, NGW, G;
};

DI int colmap(int mode, int np, int N) {
    if (mode == 0) return np < N ? np : -1;
    const int t = np >> 8, rr = np & 255, bj = rr >> 7, jj = rr & 127, j = t * 128 + jj;
    return j < DFF ? bj * DFF + j : -1;
}
DI void transpose_item(const float* __restrict__ W, int K, int N, bf16_t* __restrict__ Wt, int Np, int Kp, int mode, LAS float* scr, int item, int lane) {
    const int nblk = Np / 32, kb = item / nblk, nb = item % nblk, k0 = 64 * kb, n0 = 32 * nb;
    const int sc = colmap(mode, n0 + (lane & 31), N);
#pragma unroll 8
    for (int i = 0; i < 32; ++i) { const int kk = 2 * i + (lane >> 5), k = k0 + kk; float v = 0.f; if (sc >= 0 && k < K) v = W[(size_t)k * N + sc]; scr[kk * 33 + (lane & 31)] = v; }
    asm volatile("s_waitcnt lgkmcnt(0)" ::: "memory");
    const int c = lane & 7;
#pragma unroll
    for (int j = 0; j < 4; ++j) { const int n = (lane >> 3) + 8 * j; const LAS float* s = scr + (8 * c) * 33 + n;
        u32x4 o; o.x = pk2(s[0 * 33], s[1 * 33]); o.y = pk2(s[2 * 33], s[3 * 33]); o.z = pk2(s[4 * 33], s[5 * 33]); o.w = pk2(s[6 * 33], s[7 * 33]);
        *(u32x4*)(Wt + (size_t)(n0 + n) * Kp + k0 + 8 * c) = o; }
    asm volatile("s_waitcnt lgkmcnt(0)" ::: "memory");
}
#define TR_SET(src, dstoff, nmat, K_, N_, Np_, Kp_, mode_) { const int per = ((Kp_) / 64) * ((Np_) / 32), tot = (nmat) * per; \
    if (r < tot) { const int mi = r / per, it = r % per; transpose_item((src) + (size_t)mi * (K_) * (N_), (K_), (N_), (bf16_t*)(C.ws + (dstoff)) + (size_t)mi * (Np_) * (Kp_), (Np_), (Kp_), (mode_), scr, it, C.lane); continue; } r -= tot; }

DI void prologue(const Ctx& C) {
    LAS float* cact = (LAS float*)C.lds;
    const float* cin = C.in[1];
    for (int i = C.tid; i < NB * D; i += 512) cact[i] = fsilu(cin[i]);
    __syncthreads();
    {
        const float* adaw = C.in[3]; const float* adab = C.in[4]; float* mod = (float*)(C.ws + WS_MOD);
        for (int unit = C.gw; unit < DEPTH * 144; unit += C.NGW) {
            const int layer = unit / 144, n = (unit % 144) * 64 + C.lane;
            const float* w = adaw + (size_t)layer * D * 9216 + n;
            float acc[8];
#pragma unroll
            for (int b = 0; b < 8; ++b) acc[b] = 0.f;
            for (int k = 0; k < D; k += 4) {
                float wv[4];
#pragma unroll
                for (int j = 0; j < 4; ++j) wv[j] = w[(size_t)(k + j) * 9216];
#pragma unroll
                for (int b = 0; b < 8; ++b) { const f32x4 cv = *(const LAS f32x4*)(cact + b * D + k); acc[b] += cv[0] * wv[0] + cv[1] * wv[1] + cv[2] * wv[2] + cv[3] * wv[3]; }
            }
            const float bias = adab[layer * 9216 + n];
#pragma unroll
            for (int b = 0; b < 8; ++b) mod[((size_t)layer * 8 + b) * 9216 + n] = acc[b] + bias;
        }
    }
    {
        float* rope = (float*)(C.ws + WS_ROPE); float* lut = (float*)(C.ws + WS_LUT); const float* t5 = C.in[2];
        const int gt = C.gw * 64 + C.lane, NT = C.NGW * 64;
        for (int i = gt; i < S * 16; i += NT) {
            const int pos = i >> 4, j = i & 15;
            const float inv = exp2f(-(float)j * (1.f / 16.f) * 13.287712379549449f);
            const float ang = (float)pos * inv;
            const double rev = (double)ang * 0.15915494309189535; const double fr = rev - rint(rev);
            rope[2 * i] = __builtin_amdgcn_cosf((float)fr); rope[2 * i + 1] = __builtin_amdgcn_sinf((float)fr);
        }
        for (int i = gt; i < 16 * 132; i += NT) {
            const int slot = i / 132, d = i % 132; const int n = d > 128 ? 128 : d;
            int bucket;
            if (n < 16) bucket = n; else { const float nf = (float)n; int lg = 16 + (int)(logf(nf / 16.f) / 2.0794415416798357f * 16.f); bucket = lg < 31 ? lg : 31; }
            lut[i] = t5[bucket * 16 + slot] * L2E;
        }
    }
    {
        LAS float* scr = (LAS float*)(C.lds + 32768 + C.wave * 8704);
        constexpr int TOT = 8 * 16 * 176 + 8 * 44 * 32 + 2 * 16 * 56 + 2 * 16 * 32 + 2 * 4 * 24 + 2 * 2 * 32 + 4 * 32 * 8 + 2 * 16 * 96 + 2 * 8 * 32;
        for (int it0 = C.gw; it0 < TOT; it0 += C.NGW) {
            int r = it0;
            TR_SET(C.in[6], WS_WFI, 8, D, 2 * DFF, NFF, D, 1)
            TR_SET(C.in[7], WS_WFO, 8, DFF, D, D, DFFP, 0)
            TR_SET(C.in[8], WS_WEI, 2, D, EVC, EVCP, D, 0)
            TR_SET(C.in[9], WS_WEO, 2, D, D, D, D, 0)
            TR_SET(C.in[12], WS_WUQ, 2, 256, 768, 768, 256, 0)
            TR_SET(C.in[13], WS_WUKV, 2, 128, 1024, 1024, 128, 0)
            TR_SET(C.in[16], WS_WC1, 4, 2048, 256, 256, 2048, 0)
            TR_SET(C.in[19], WS_WOI, 2, D, ODC, ODC, D, 0)
            TR_SET(C.in[20], WS_WOO, 2, 512, D, D, 512, 0)
        }
    }
}

DI void norm_phase(const Ctx& C, const float* xsrc, int layer, int sub) {
    const float* g = C.in[5] + (size_t)(layer * 3 + sub) * D;
    const float* mod = (const float*)(C.ws + WS_MOD) + (size_t)layer * 8 * 9216 + sub * 3072;
    bf16_t* Y = (bf16_t*)(C.ws + WS_Y);
    for (int row = C.gw; row < M; row += C.NGW) {
        const f32x4* xr = (const f32x4*)(xsrc + (size_t)row * D) + C.lane;
        f32x4 v[4]; float ss = 0.f;
#pragma unroll
        for (int j = 0; j < 4; ++j) { v[j] = xr[64 * j]; ss += v[j][0] * v[j][0] + v[j][1] * v[j][1] + v[j][2] * v[j][2] + v[j][3] * v[j][3]; }
        const float rinv = rsqrtf(wave_sum(ss) * (1.f / D) + EPS);
        const float* mb = mod + (size_t)(row >> 11) * 9216;
        u32x2* o = (u32x2*)(Y + (size_t)row * D) + C.lane;
#pragma unroll
        for (int j = 0; j < 4; ++j) { const int c = 4 * C.lane + 256 * j;
            const f32x4 gv = *(const f32x4*)(g + c), sh = *(const f32x4*)(mb + c), scl = *(const f32x4*)(mb + 1024 + c);
            f32x4 y; for (int e = 0; e < 4; ++e) y[e] = v[j][e] * rinv * gv[e] * (1.f + scl[e]) + sh[e];
            u32x2 w; w.x = pk2(y[0], y[1]); w.y = pk2(y[2], y[3]); o[64 * j] = w; }
    }
}

DI void norm64_8(const bf16_t* src, bf16_t* dst, const float* g, int lane, bool active) {
    u32x4 w = {0u, 0u, 0u, 0u};
    if (active) w = *(const u32x4*)src;
    float v[8] = {bflo(w.x), bfhi(w.x), bflo(w.y), bfhi(w.y), bflo(w.z), bfhi(w.z), bflo(w.w), bfhi(w.w)};
    float ss = 0.f;
#pragma unroll
    for (int e = 0; e < 8; ++e) ss += v[e] * v[e];
    ss += shx(ss, 1); ss += shx(ss, 2); ss += shx(ss, 4);
    const float rinv = rsqrtf(ss * (1.f / 64.f) + EPS);
    if (active) { const float* gg = g + 8 * (lane & 7);
        u32x4 o; o.x = pk2(v[0] * rinv * gg[0], v[1] * rinv * gg[1]); o.y = pk2(v[2] * rinv * gg[2], v[3] * rinv * gg[3]);
        o.z = pk2(v[4] * rinv * gg[4], v[5] * rinv * gg[5]); o.w = pk2(v[6] * rinv * gg[6], v[7] * rinv * gg[7]);
        *(u32x4*)dst = o; }
}

DI void epost1(const Ctx& C, int j) {
    const bf16_t* U = (const bf16_t*)(C.ws + WS_U);
    bf16_t* CQN = (bf16_t*)(C.ws + WS_CQN); bf16_t* CKVN = (bf16_t*)(C.ws + WS_CKVN); bf16_t* KROPE = (bf16_t*)(C.ws + WS_KROPE);
    bf16_t* NQ = (bf16_t*)(C.ws + WS_NQ); bf16_t* NKS = (bf16_t*)(C.ws + WS_NKS); bf16_t* NKW = (bf16_t*)(C.ws + WS_NKW);
    float* GT = (float*)(C.ws + WS_GT); bf16_t* ACMP = (bf16_t*)(C.ws + WS_ACMP);
    const float* rope = (const float*)(C.ws + WS_ROPE);
    const float* qng = C.in[10] + j * 256; const float* kvng = C.in[11] + j * 128; const float* mqk = C.in[14] + j * 192;
    const float* pe = C.in[15] + (size_t)j * 2 * 32 * 64; const float* nqk = C.in[18] + j * 128;
    const int lane = C.lane;
    for (int row = C.gw; row < M; row += C.NGW) {
        const int b = row >> 11, t = row & 2047;
        const bf16_t* ur = U + (size_t)row * EVCP;
        {
            const u32x2 w = *(const u32x2*)(ur + 4 * lane);
            float v[4] = {bflo(w.x), bfhi(w.x), bflo(w.y), bfhi(w.y)};
            const float ss = wave_sum(v[0] * v[0] + v[1] * v[1] + v[2] * v[2] + v[3] * v[3]);
            const float rinv = rsqrtf(ss * (1.f / 256.f) + EPS); const f32x4 g = *(const f32x4*)(qng + 4 * lane);
            u32x2 o; o.x = pk2(v[0] * rinv * g[0], v[1] * rinv * g[1]); o.y = pk2(v[2] * rinv * g[2], v[3] * rinv * g[3]);
            *(u32x2*)(CQN + (size_t)row * 256 + 4 * lane) = o;
        }
        {
            const unsigned w = *(const unsigned*)(ur + 256 + 2 * lane);
            const float v0 = bflo(w), v1 = bfhi(w);
            const float ss = wave_sum(v0 * v0 + v1 * v1);
            const float rinv = rsqrtf(ss * (1.f / 128.f) + EPS);
            *(unsigned*)(CKVN + (size_t)row * 128 + 2 * lane) = pk2(v0 * rinv * kvng[2 * lane], v1 * rinv * kvng[2 * lane + 1]);
        }
        {
            const float v = lane < 32 ? bf1(ur[384 + lane]) : 0.f;
            const float ss = wave_sum(v * v);
            const float rinv = rsqrtf(ss * (1.f / 32.f) + EPS);
            const float vn = v * rinv * mqk[96 + 64 + (lane & 31)];
            const float pt = shx(vn, 16);
            const int i = lane & 15; const float cs = rope[(t * 16 + i) * 2], sn = rope[(t * 16 + i) * 2 + 1];
            const float o = (lane < 16) ? vn * cs - pt * sn : vn * cs + pt * sn;
            if (lane < 32) KROPE[(size_t)row * 32 + lane] = (bf16_t)f2bf(o);
        }
        norm64_8(ur + 416 + 8 * lane, NQ + (size_t)row * 512 + 8 * lane, nqk, lane, true);
        {
#pragma unroll
            for (int which = 0; which < 2; ++which) {
                const unsigned w = *(const unsigned*)(ur + (which ? 1440 : 1184) + 2 * lane);
                const float v0 = bflo(w), v1 = bfhi(w); float ss = v0 * v0 + v1 * v1;
                ss += shx(ss, 1); ss += shx(ss, 2); ss += shx(ss, 4); ss += shx(ss, 8); ss += shx(ss, 16);
                const float rinv = rsqrtf(ss * (1.f / 64.f) + EPS); const int d = 2 * (lane & 31);
                *(unsigned*)((which ? NKW : NKS) + (size_t)row * 128 + 2 * lane) = pk2(v0 * rinv * nqk[64 + d], v1 * rinv * nqk[64 + d + 1]);
            }
        }
        {
            const int n1 = t >> 4, l1 = t & 15, g = lane >> 5, d = 2 * (lane & 31);
#pragma unroll
            for (int kind = 0; kind < 2; ++kind) {
                const unsigned w = *(const unsigned*)(ur + 928 + kind * 128 + 2 * lane);
                const float v0 = bflo(w), v1 = bfhi(w);
                bf16_t* A = ACMP + (size_t)kind * 2048 * 2048;
                const float* pk = pe + kind * 2048;
                if (n1 <= 126) { const size_t ra = (size_t)((b * 127 + n1) * 2 + g); *(unsigned*)(A + ra * 2048 + l1 * 64 + d) = pk2(v0 + pk[l1 * 64 + d], v1 + pk[l1 * 64 + d + 1]); }
                if (n1 >= 1) { const int l2 = l1 + 16; const size_t ra = (size_t)((b * 127 + n1 - 1) * 2 + g); *(unsigned*)(A + ra * 2048 + l2 * 64 + d) = pk2(v0 + pk[l2 * 64 + d], v1 + pk[l2 * 64 + d + 1]); }
            }
        }
        if (lane < 24) { const float x = bf1(ur[1696 + lane]); GT[(size_t)row * 24 + lane] = 1.f / (1.f + __expf(-x)); }
    }
}

DI void epost2(const Ctx& C, int j) {
    const bf16_t* QFULL = (const bf16_t*)(C.ws + WS_QFULL); const bf16_t* KVFULL = (const bf16_t*)(C.ws + WS_KVFULL);
    const bf16_t* KROPE = (const bf16_t*)(C.ws + WS_KROPE);
    bf16_t* QF = (bf16_t*)(C.ws + WS_QF); bf16_t* KF = (bf16_t*)(C.ws + WS_KF);
    const float* rope = (const float*)(C.ws + WS_ROPE);
    const float* mqk = C.in[14] + j * 192; const float* nqk = C.in[18] + j * 128;
    const int lane = C.lane, head = lane >> 3, c = lane & 7;
    for (int row = C.gw; row < M; row += C.NGW) {
        const int t = row & 2047;
        const bf16_t* qr = QFULL + (size_t)row * 768 + head * 96; const bf16_t* kvr = KVFULL + (size_t)row * 1024 + head * 128;
        bf16_t* qo = QF + (size_t)row * 768 + head * 96; bf16_t* ko = KF + (size_t)row * 768 + head * 96;
        norm64_8(qr + 8 * c, qo + 8 * c, mqk, lane, true);
        norm64_8(kvr + 8 * c, ko + 8 * c, mqk + 96, lane, true);
        {
            const u32x2 w = *(const u32x2*)(qr + 64 + 4 * c);
            float v[4] = {bflo(w.x), bfhi(w.x), bflo(w.y), bfhi(w.y)};
            float ss = v[0] * v[0] + v[1] * v[1] + v[2] * v[2] + v[3] * v[3];
            ss += shx(ss, 1); ss += shx(ss, 2); ss += shx(ss, 4);
            const float rinv = rsqrtf(ss * (1.f / 32.f) + EPS);
            float o[4];
#pragma unroll
            for (int e = 0; e < 4; ++e) {
                const float vn = v[e] * rinv * mqk[64 + 4 * c + e];
                const float pt = shx(vn, 4);
                const int i = 4 * (c & 3) + e; const float cs = rope[(t * 16 + i) * 2], sn = rope[(t * 16 + i) * 2 + 1];
                o[e] = (c < 4) ? vn * cs - pt * sn : vn * cs + pt * sn;
            }
            u32x2 ow; ow.x = pk2(o[0], o[1]); ow.y = pk2(o[2], o[3]);
            *(u32x2*)(qo + 64 + 4 * c) = ow;
        }
        *(u32x2*)(ko + 64 + 4 * c) = *(const u32x2*)(KROPE + (size_t)row * 32 + 4 * c);
    }
    const bf16_t* HID = (const bf16_t*)(C.ws + WS_HID); bf16_t* KCMP = (bf16_t*)(C.ws + WS_KCMP); bf16_t* VCMP = (bf16_t*)(C.ws + WS_VCMP);
    const float* w2 = C.in[17] + (size_t)j * 2 * 256 * 64;
    for (int unit = C.gw; unit < 2 * 2032; unit += C.NGW) {
        const int kind = unit / 2032, rc = unit % 2032;
        const u32x2 hw = *(const u32x2*)(HID + (size_t)kind * 2048 * 256 + (size_t)rc * 256 + 4 * lane);
        const float hv[4] = {bflo(hw.x), bfhi(hw.x), bflo(hw.y), bfhi(hw.y)};
        const float* w = w2 + kind * 256 * 64 + lane;
        float acc = 0.f;
#pragma unroll 8
        for (int jj = 0; jj < 64; ++jj) {
#pragma unroll
            for (int e = 0; e < 4; ++e) acc += __builtin_bit_cast(float, __builtin_amdgcn_readlane(__builtin_bit_cast(int, hv[e]), jj)) * w[(4 * jj + e) * 64];
        }
        if (kind == 0) { const float ss = wave_sum(acc * acc); acc = acc * rsqrtf(ss * (1.f / 64.f) + EPS) * nqk[64 + lane]; KCMP[(size_t)rc * 64 + lane] = (bf16_t)f2bf(acc); }
        else VCMP[(size_t)rc * 64 + lane] = (bf16_t)f2bf(acc);
    }
}

DI void opost(const Ctx& C, int j) {
    const bf16_t* U = (const bf16_t*)(C.ws + WS_U); bf16_t* NRM = (bf16_t*)(C.ws + WS_NRM);
    const float* dg = C.in[21] + j * 128; const float* mg = C.in[22] + j * 128;
    const int lane = C.lane, hf = lane >> 5, l5 = lane & 31;
    for (int row = C.gw; row < M; row += C.NGW) {
        const bf16_t* ur = U + (size_t)row * ODC; bf16_t* nr = NRM + (size_t)row * 2048;
        norm64_8(ur + 8 * lane, nr + 8 * lane, dg, lane, true);
        norm64_8(ur + 768 + 8 * lane, nr + 768 + 8 * lane, dg + 64, lane, true);
        norm64_8(ur + hf * 768 + 512 + 8 * l5, nr + hf * 768 + 512 + 8 * l5, dg + hf * 64, lane, true);
        norm64_8(ur + 2304 + hf * 256 + 8 * l5, nr + 1536 + hf * 256 + 8 * l5, mg + hf * 64, lane, true);
    }
    float* KM = (float*)(C.ws + WS_KMEAN);
    if (C.wave == 0) {
        for (int unit = blockIdx.x; unit < 256; unit += C.G) {
            const int b = unit >> 5, hh = (unit >> 3) & 3, blk = unit & 7;
            const bf16_t* kp = U + (size_t)(b * S + blk * 256) * ODC + 2560 + hh * 64 + lane;
            const float g = mg[64 + lane]; float acc = 0.f;
            for (int i = 0; i < 256; ++i) { const float v = bf1(kp[(size_t)i * ODC]); const float ss = wave_sum(v * v); acc += v * rsqrtf(ss * (1.f / 64.f) + EPS) * g; }
            KM[unit * 64 + lane] = acc * (1.f / 256.f);
        }
    }
}

DI int next_item(unsigned* ctr, int lane) {
    int it = 0;
    if (lane == 0) it = (int)__hip_atomic_fetch_add(ctr, 1u, __ATOMIC_RELAXED, __HIP_MEMORY_SCOPE_AGENT);
    return __builtin_amdgcn_readfirstlane(it);
}

DI void eattn(const Ctx& C, unsigned* ctr) {
    LAS char* wl = (LAS char*)C.lds + C.wave * WL_BYTES;
    const int lane = C.lane, r = lane & 31, h = lane >> 5;
    const bf16_t* U = (const bf16_t*)(C.ws + WS_U); const bf16_t* NQ = (const bf16_t*)(C.ws + WS_NQ);
    const bf16_t* NKS = (const bf16_t*)(C.ws + WS_NKS); const bf16_t* NKW = (const bf16_t*)(C.ws + WS_NKW);
    const bf16_t* KCMP = (const bf16_t*)(C.ws + WS_KCMP); const bf16_t* VCMP = (const bf16_t*)(C.ws + WS_VCMP);
    const bf16_t* QF = (const bf16_t*)(C.ws + WS_QF); const bf16_t* KF = (const bf16_t*)(C.ws + WS_KF); const bf16_t* KVFULL = (const bf16_t*)(C.ws + WS_KVFULL);
    const float* GT = (const float*)(C.ws + WS_GT); const float* lutg = (const float*)(C.ws + WS_LUT);
    bf16_t* CAT = (bf16_t*)(C.ws + WS_CAT);
    const float sc64 = 0.125f * L2E, sc96 = 0.10206207261596575f * L2E;
    constexpr int NNSA = 1024, NMLA = 4096, BIG = 1 << 20;
    for (;;) {
        const int it = next_item(ctr, lane);
        if (it >= NNSA + NMLA) break;
        if (it < NNSA) {
            const int qt = 63 - (it >> 4), b = (it >> 1) & 7, g = it & 1;
            const int qs = qt * 32, tok = b * S + qs + r, qpos = qs + r;
            LAS float* imp = (LAS float*)(wl + WL_IMP);
            for (int i = lane; i < 32 * 33; i += 64) imp[i] = 0.f;
            const bf16_t* kc = KCMP + (size_t)(b * 127 * 2 + g) * 64; const bf16_t* vc = VCMP + (size_t)(b * 127 * 2 + g) * 64;
            for (int p = 0; p < 4; ++p) {
                lut_write(wl, lutg, 8 + g * 4 + p, lane);
                bf16x8 qf[4]; q_load<4>(qf, NQ + (size_t)tok * 512 + (g * 4 + p) * 64, h);
                float mx = -1e30f, sum = 0.f;
                for (int tt = 0; tt < 4; ++tt) {
                    KVRegs<64> R; kv_load<64>(R, kc, 128, nullptr, 0, 0, 1, 32 * tt, 127, lane);
                    kv_stage<64>(R, wl, false, lane);
                    f32x16 Sx;
                    qk_tile<64>(Sx, wl, qf, 32 * tt, 127, 31, 16, qpos, BIG, 0u, 0, false, true, sc64, lane);
                    float tm = Sx[0];
#pragma unroll
                    for (int i = 1; i < 16; ++i) tm = fmaxf(tm, Sx[i]);
                    tm = fmaxf(tm, shx(tm, 32));
                    const float mn = fmaxf(mx, tm); sum *= __builtin_amdgcn_exp2f(mx - mn); mx = mn;
#pragma unroll
                    for (int i = 0; i < 16; ++i) sum += Sx[i] > -5e29f ? __builtin_amdgcn_exp2f(Sx[i] - mn) : 0.f;
                }
                sum += shx(sum, 32);
                const float inv = 1.f / fmaxf(sum, 1e-30f);
                for (int tt = 0; tt < 4; ++tt) {
                    KVRegs<64> R; kv_load<64>(R, kc, 128, nullptr, 0, 0, 1, 32 * tt, 127, lane);
                    kv_stage<64>(R, wl, false, lane);
                    f32x16 Sx;
                    qk_tile<64>(Sx, wl, qf, 32 * tt, 127, 31, 16, qpos, BIG, 0u, 0, false, true, sc64, lane);
#pragma unroll
                    for (int i = 0; i < 16; ++i) Sx[i] = Sx[i] > -5e29f ? __builtin_amdgcn_exp2f(Sx[i] - mx) * inv : 0.f;
#pragma unroll
                    for (int g4 = 0; g4 < 4; ++g4) { const int mb = 8 * tt + 2 * g4 + h;
                        imp[r * 33 + mb] += Sx[4 * g4] + Sx[4 * g4 + 1] + Sx[4 * g4 + 2] + 0.5f * Sx[4 * g4 + 3]; }
                    asm volatile("s_waitcnt lgkmcnt(0)" ::: "memory");
#pragma unroll
                    for (int g4 = 0; g4 < 4; ++g4) { const int mb = 8 * tt + 2 * g4 + h + 1;
                        imp[r * 33 + mb] += 0.5f * Sx[4 * g4 + 3]; }
                    asm volatile("s_waitcnt lgkmcnt(0)" ::: "memory");
                }
            }
            unsigned selmask;
            {
                const int cur = qpos >> 6;
                unsigned mask = 1u | (1u << cur) | (cur > 0 ? (1u << (cur - 1)) : 0u);
                const int nforced = __popc(mask); const int tot = cur + 1 < 8 ? cur + 1 : 8; const int need = tot - nforced;
                unsigned cand = (cur >= 31 ? 0xffffffffu : ((2u << cur) - 1u)) & ~mask;
                float v[32];
#pragma unroll
                for (int mm = 0; mm < 32; ++mm) v[mm] = imp[r * 33 + mm];
#pragma unroll
                for (int k = 0; k < 5; ++k) {
                    if (k < need) {
                        float bv = -1.f; int best = 0;
#pragma unroll
                        for (int mm = 0; mm < 32; ++mm) { const bool ok = ((cand >> mm) & 1u) && v[mm] > bv; bv = ok ? v[mm] : bv; best = ok ? mm : best; }
                        mask |= 1u << best; cand &= ~(1u << best);
                    }
                }
                selmask = mask;
            }
#ifndef X_NOP2
            for (int p = 0; p < 4; ++p) {
                const int hd = g * 4 + p;
                lut_write(wl, lutg, 8 + hd, lane);
                bf16x8 qf[4]; q_load<4>(qf, NQ + (size_t)tok * 512 + hd * 64, h);
                const float g0 = GT[(size_t)tok * 24 + hd * 3], g1 = GT[(size_t)tok * 24 + hd * 3 + 1], g2 = GT[(size_t)tok * 24 + hd * 3 + 2];
                LAS float* cb = (LAS float*)(wl + WL_IMP);
                {
                    f32x16 O[2]; o_zero(O); float m = -1e30f, l = 0.f;
                    attn_core<64>(wl, qf, kc, 128, vc, 128, 0, 1, 31, 16, 0, 128, 127, qpos, BIG, 0u, 0, false, true, sc64, O, m, l, lane);
                    l += shx(l, 32); const float f = g0 / fmaxf(l, 1e-30f);
#pragma unroll
                    for (int db = 0; db < 2; ++db)
#pragma unroll
                        for (int i = 0; i < 16; ++i) cb[(32 * db + crow(i, h)) * 32 + r] = O[db][i] * f;
                }
                {
                    f32x16 O[2]; o_zero(O); float m = -1e30f, l = 0.f;
                    attn_core<64>(wl, qf, NKS + g * 64, 128, U + 1312 + g * 64, EVCP, b * S, 1, 0, 1, 0, qs + 32, S, qpos, BIG, selmask, 6, true, true, sc64, O, m, l, lane);
                    l += shx(l, 32); const float f = g1 / fmaxf(l, 1e-30f);
#pragma unroll
                    for (int db = 0; db < 2; ++db)
#pragma unroll
                        for (int i = 0; i < 16; ++i) cb[(32 * db + crow(i, h)) * 32 + r] += O[db][i] * f;
                }
                {
                    f32x16 O[2]; o_zero(O); float m = -1e30f, l = 0.f;
                    int ilo = qs - 511; ilo = ilo < 0 ? 0 : (ilo & ~31);
                    attn_core<64>(wl, qf, NKW + g * 64, 128, U + 1568 + g * 64, EVCP, b * S, 1, 0, 1, ilo, qs + 32, S, qpos, 511, 0u, 0, false, true, sc64, O, m, l, lane);
                    l += shx(l, 32); const float f = g2 / fmaxf(l, 1e-30f);
#pragma unroll
                    for (int db = 0; db < 2; ++db)
#pragma unroll
                        for (int i = 0; i < 16; ++i) O[db][i] = O[db][i] * f + cb[(32 * db + crow(i, h)) * 32 + r];
                    o_store(CAT + (size_t)tok * 1024 + 512 + hd * 64, O, 1.f, h);
                }
            }
#endif
        } else {
            const int jx = it - NNSA, qt = 63 - (jx >> 6), b = (jx >> 3) & 7, hh = jx & 7;
            const int qs = qt * 32, tok = b * S + qs + r, qpos = qs + r;
            bf16x8 qf[6]; q_load<6>(qf, QF + (size_t)tok * 768 + hh * 96, h);
            f32x16 O[2]; o_zero(O); float m = -1e30f, l = 0.f;
#ifndef X_NOMLA
            attn_core<96>(wl, qf, KF + hh * 96, 768, KVFULL + hh * 128 + 64, 1024, b * S, 1, 0, 1, 0, qs + 32, S, qpos, BIG, 0u, 0, false, false, sc96, O, m, l, lane);
#endif
            l += shx(l, 32);
            o_store(CAT + (size_t)tok * 1024 + hh * 64, O, 1.f / fmaxf(l, 1e-30f), h);
        }
    }
}

DI void oattn(const Ctx& C, unsigned* ctr) {
    LAS char* wl = (LAS char*)C.lds + C.wave * WL_BYTES;
    const int lane = C.lane, r = lane & 31, h = lane >> 5;
    const bf16_t* U = (const bf16_t*)(C.ws + WS_U); const bf16_t* NRM = (const bf16_t*)(C.ws + WS_NRM);
    const float* KM = (const float*)(C.ws + WS_KMEAN); const float* lutg = (const float*)(C.ws + WS_LUT);
    bf16_t* CAT = (bf16_t*)(C.ws + WS_CAT);
    const float sc64 = 0.125f * L2E;
    constexpr int NDIL = 2048, NMOBA = 2048, BIG = 1 << 20;
    for (;;) {
        const int it = next_item(ctr, lane);
        if (it >= NDIL + NMOBA) break;
        if (it < NDIL) {
            const int itq = 3 - (it >> 9), b = (it >> 6) & 7, hh = (it >> 4) & 3, rho = it & 15;
            const int qpos = rho + 16 * (32 * itq + r), tok = b * S + qpos;
            f32x16 O[2]; o_zero(O); float m = -1e30f, l = 0.f;
            {
                const int slot = 8 + hh; lut_write(wl, lutg, slot, lane);
                bf16x8 qf[4]; q_load<4>(qf, NRM + (size_t)tok * 2048 + slot * 64, h);
                attn_core<64>(wl, qf, NRM + 768 + slot * 64, 2048, U + 1536 + slot * 64, ODC, b * S + rho, 16, rho, 16, 0, 32 * itq + 32, 128, qpos, BIG, 0u, 0, false, true, sc64, O, m, l, lane);
            }
            {
                const int slot = 4 + hh; lut_write(wl, lutg, slot, lane);
                bf16x8 qf[4]; q_load<4>(qf, NRM + (size_t)tok * 2048 + slot * 64, h);
                const int rho4 = rho & 3; int ilo = 128 * itq - 128; ilo = ilo < 0 ? 0 : ilo;
                attn_core<64>(wl, qf, NRM + 768 + slot * 64, 2048, U + 1536 + slot * 64, ODC, b * S + rho4, 4, rho4, 4, ilo, 128 * itq + 128, 512, qpos, 512, 0u, 0, false, true, sc64, O, m, l, lane);
            }
            {
                const int slot = hh; lut_write(wl, lutg, slot, lane);
                bf16x8 qf[4]; q_load<4>(qf, NRM + (size_t)tok * 2048 + slot * 64, h);
                const int t0 = rho + 512 * itq; int ilo = t0 - 128; ilo = ilo < 0 ? 0 : (ilo & ~31);
                attn_core<64>(wl, qf, NRM + 768 + slot * 64, 2048, U + 1536 + slot * 64, ODC, b * S, 1, 0, 1, ilo, t0 + 497, S, qpos, 128, 0u, 0, false, true, sc64, O, m, l, lane);
            }
            l += shx(l, 32);
            o_store(CAT + (size_t)tok * 512 + hh * 64, O, 1.f / fmaxf(l, 1e-30f), h);
        } else {
            const int jx = it - NDIL, qt = 63 - (jx >> 5), b = (jx >> 2) & 7, hh = jx & 3;
            const int qs = qt * 32, tok = b * S + qs + r, qpos = qs + r, own = qs >> 8;
            lut_write(wl, lutg, 12 + hh, lane);
            const bf16_t* qrow = NRM + (size_t)tok * 2048 + 1536 + hh * 64;
            bf16x8 qf[4]; q_load<4>(qf, qrow, h);
            unsigned mask = 1u << own;
            if (own > 0) {
                float sc[8];
#pragma unroll
                for (int n = 0; n < 8; ++n) sc[n] = 0.f;
                const float* km = KM + (size_t)((b * 4 + hh) * 8) * 64;
                for (int d8 = 0; d8 < 8; ++d8) {
                    const u32x4 w = *(const u32x4*)(qrow + 8 * d8);
                    const float qv[8] = {bflo(w.x), bfhi(w.x), bflo(w.y), bfhi(w.y), bflo(w.z), bfhi(w.z), bflo(w.w), bfhi(w.w)};
#pragma unroll
                    for (int n = 0; n < 8; ++n)
#pragma unroll
                        for (int e = 0; e < 8; ++e) sc[n] += qv[e] * km[n * 64 + 8 * d8 + e];
                }
                const int need = own < 3 ? own : 3; unsigned cand = (1u << own) - 1u;
#pragma unroll
                for (int k = 0; k < 3; ++k) {
                    if (k < need) {
                        float bv = -3e38f; int best = 0;
#pragma unroll
                        for (int n = 0; n < 8; ++n) { const bool ok = ((cand >> n) & 1u) && sc[n] > bv; bv = ok ? sc[n] : bv; best = ok ? n : best; }
                        mask |= 1u << best; cand &= ~(1u << best);
                    }
                }
            }
            f32x16 O[2]; o_zero(O); float m = -1e30f, l = 0.f;
            attn_core<64>(wl, qf, NRM + 1792 + hh * 64, 2048, U + 2816 + hh * 64, ODC, b * S, 1, 0, 1, 0, qs + 32, S, qpos, BIG, mask, 8, true, true, sc64, O, m, l, lane);
            l += shx(l, 32);
            o_store(CAT + (size_t)tok * 512 + 256 + hh * 64, O, 1.f / fmaxf(l, 1e-30f), h);
        }
    }
}

enum { K_PRO = 0, K_NORM, K_FFI, K_RESID, K_MIXIN, K_EPOST1, K_EGEMM2, K_EPOST2, K_EATTN, K_OPOST, K_OATTN };
constexpr int NPHASE = 1 + 13 + 11 + 13 + 11;

__global__ void __launch_bounds__(512, 2) fwd_kernel(Args args) {
    extern __shared__ __attribute__((aligned(16))) unsigned char lds_raw[];
    cg::grid_group grid = cg::this_grid();
    Ctx C;
    C.in = args.in; C.out = args.out; C.ws = args.ws; C.lds = (LAS unsigned char*)lds_raw;
    C.tid = threadIdx.x; C.lane = C.tid & 63; C.wave = __builtin_amdgcn_readfirstlane(C.tid >> 6);
    C.G = gridDim.x; C.gw = blockIdx.x * 8 + C.wave; C.NGW = C.G * 8;
    unsigned* ctl = (unsigned*)(C.ws + WS_CTL);
    const int lo = args.ph_lo, hi = args.ph_hi;
    for (int p = lo; p < hi; ++p) {
        { int t_ = threadIdx.x; asm volatile("" : "+v"(t_)); C.tid = t_; C.lane = t_ & 63; }
        int kind = K_PRO, layer = 0, sub = 0;
        if (p > 0) {
            int q = p - 1;
            if (q < 13) layer = 0; else if (q < 24) { layer = 1; q -= 13; } else if (q < 37) { layer = 2; q -= 24; } else { layer = 3; q -= 37; }
            if (q < 3) { sub = 0; kind = q == 0 ? K_NORM : (q == 1 ? K_FFI : K_RESID); }
            else if ((layer & 1) == 0) {
                if (q >= 10) { sub = 2; const int e = q - 10; kind = e == 0 ? K_NORM : (e == 1 ? K_FFI : K_RESID); }
                else { sub = 1; const int e = q - 3; kind = e == 0 ? K_NORM : e == 1 ? K_MIXIN : e == 2 ? K_EPOST1 : e == 3 ? K_EGEMM2 : e == 4 ? K_EPOST2 : e == 5 ? K_EATTN : K_RESID; }
            } else {
                if (q >= 8) { sub = 2; const int e = q - 8; kind = e == 0 ? K_NORM : (e == 1 ? K_FFI : K_RESID); }
                else { sub = 1; const int e = q - 3; kind = e == 0 ? K_NORM : e == 1 ? K_MIXIN : e == 2 ? K_OPOST : e == 3 ? K_OATTN : K_RESID; }
            }
        }
        const int j = layer >> 1; const bool even = (layer & 1) == 0;
        const float* xcur = (layer == 0 && sub == 0) ? C.in[0] : C.out;
#ifndef DIS_PRO
        if (kind == K_PRO) prologue(C);
#else
        if (0) {}
#endif
        else if (kind == K_NORM) norm_phase(C, xcur, layer, sub);
        else if (kind == K_FFI) {
            pg8::Gemm g{(const bf16_t*)(C.ws + WS_Y), (const bf16_t*)(C.ws + WS_WFI) + (size_t)(layer * 2 + (sub >> 1)) * NFF * D, M, NFF, D};
            pg8::StaticOrder So; So.init(M, NFF, C.G, (int)blockIdx.x);
            pg8::EpiSwiglu E{(bf16_t*)(C.ws + WS_H), DFFP};
#ifndef DIS_G1
            pg8::gemm_phase<pg8::EpiSwiglu, pg8::StaticOrder, true>(C.lds, g, So, E);
#endif
        } else if (kind == K_RESID) {
            pg8::Gemm g; float gmul;
            if (sub != 1) { g = pg8::Gemm{(const bf16_t*)(C.ws + WS_H), (const bf16_t*)(C.ws + WS_WFO) + (size_t)(layer * 2 + (sub >> 1)) * D * DFFP, M, D, DFFP}; gmul = 0.5f; }
            else if (even) { g = pg8::Gemm{(const bf16_t*)(C.ws + WS_CAT), (const bf16_t*)(C.ws + WS_WEO) + (size_t)j * D * D, M, D, D}; gmul = 1.f; }
            else { g = pg8::Gemm{(const bf16_t*)(C.ws + WS_CAT), (const bf16_t*)(C.ws + WS_WOO) + (size_t)j * D * 512, M, D, 512}; gmul = 1.f; }
            pg8::StaticOrder So; So.init(M, D, C.G, (int)blockIdx.x);
            pg8::EpiResid E{xcur, C.out, (const float*)(C.ws + WS_MOD) + (size_t)layer * 8 * 9216 + sub * 3072 + 2048, gmul};
#ifndef DIS_G2
            pg8::gemm_phase<pg8::EpiResid, pg8::StaticOrder, false>(C.lds, g, So, E);
#endif
        } else if (kind == K_MIXIN || kind == K_EGEMM2) {
            const int g_lo = kind == K_MIXIN ? 0 : 1, g_hi = kind == K_MIXIN ? 1 : 5;
            for (int gi = g_lo; gi < g_hi; ++gi) {
                pg8::Gemm g; pg8::EpiBf16 E; int shift = 0;
                if (gi == 0) {
                    if (even) { g = pg8::Gemm{(const bf16_t*)(C.ws + WS_Y), (const bf16_t*)(C.ws + WS_WEI) + (size_t)j * EVCP * D, M, EVCP, D}; E = pg8::EpiBf16{(bf16_t*)(C.ws + WS_U), EVCP, 0}; }
                    else { g = pg8::Gemm{(const bf16_t*)(C.ws + WS_Y), (const bf16_t*)(C.ws + WS_WOI) + (size_t)j * ODC * D, M, ODC, D}; E = pg8::EpiBf16{(bf16_t*)(C.ws + WS_U), ODC, 0}; }
                } else if (gi <= 2) {
                    const int kd = gi - 1;
                    g = pg8::Gemm{(const bf16_t*)(C.ws + WS_ACMP) + (size_t)kd * 2048 * 2048, (const bf16_t*)(C.ws + WS_WC1) + (size_t)(j * 2 + kd) * 256 * 2048, 2048, 256, 2048};
                    E = pg8::EpiBf16{(bf16_t*)(C.ws + WS_HID) + (size_t)kd * 2048 * 256, 256, 1}; shift = kd * 8;
                } else if (gi == 3) {
                    g = pg8::Gemm{(const bf16_t*)(C.ws + WS_CQN), (const bf16_t*)(C.ws + WS_WUQ) + (size_t)j * 768 * 256, M, 768, 256};
                    E = pg8::EpiBf16{(bf16_t*)(C.ws + WS_QFULL), 768, 0}; shift = 16;
                } else {
                    g = pg8::Gemm{(const bf16_t*)(C.ws + WS_CKVN), (const bf16_t*)(C.ws + WS_WUKV) + (size_t)j * 1024 * 128, M, 1024, 128};
                    E = pg8::EpiBf16{(bf16_t*)(C.ws + WS_KVFULL), 1024, 0}; shift = 208;
                }
                pg8::StaticOrder So; So.init(g.M, g.N, C.G, ((int)blockIdx.x - shift % C.G + C.G) % C.G);
#ifndef DIS_G3
                pg8::gemm_phase<pg8::EpiBf16, pg8::StaticOrder, true>(C.lds, g, So, E);
#endif
            }
        }
#ifndef DIS_EP1
        else if (kind == K_EPOST1) epost1(C, j);
#endif
#ifndef DIS_EP2
        else if (kind == K_EPOST2) epost2(C, j);
#endif
#ifndef DIS_EATTN
        else if (kind == K_EATTN) eattn(C, ctl + 64 * p);
#endif
#ifndef DIS_OPOST
        else if (kind == K_OPOST) opost(C, j);
#endif
#ifndef DIS_OATTN
        else if (kind == K_OATTN) oattn(C, ctl + 64 * p);
#endif
        if (p + 1 < hi) grid.sync();
    }
}

extern "C" void kernel_launch(void* const* d_in, const int* in_sizes, int n_in, void* d_out, int out_size, void* d_ws, size_t ws_size, hipStream_t stream) {
    static int grid = 0;
    if (grid == 0) {
        if (n_in != 23 || out_size != M * D || ws_size < WS_END) { fprintf(stderr, "kernel_launch: unexpected sizes n_in %d out %d ws %zu\n", n_in, out_size, ws_size); grid = -1; return; }
        int dev = 0, cus = 0, per_cu = 0;
        hipGetDevice(&dev); hipDeviceGetAttribute(&cus, hipDeviceAttributeMultiprocessorCount, dev);
        hipFuncSetAttribute((const void*)fwd_kernel, hipFuncAttributeMaxDynamicSharedMemorySize, LDS_BYTES);
        hipOccupancyMaxActiveBlocksPerMultiprocessor(&per_cu, (const void*)fwd_kernel, 512, LDS_BYTES);
        (void)hipGetLastError();
        if (per_cu < 1) per_cu = 1;
        grid = cus * 1;
        fprintf(stderr, "kernel_launch: cus %d per_cu %d grid %d\n", cus, per_cu, grid);
    }
    if (grid < 0) return;
    hipMemsetAsync((char*)d_ws + WS_CTL, 0, CTL_BYTES, stream);
    Args a{};
    for (int i = 0; i < 23; ++i) a.in[i] = (const float*)d_in[i];
    a.out = (float*)d_out; a.ws = (unsigned char*)d_ws; a.ph_lo = 0; a.ph_hi = NPHASE;
    void* kargs[] = {&a};
    hipError_t e = hipLaunchCooperativeKernel((const void*)fwd_kernel, dim3(grid), dim3(512), kargs, LDS_BYTES, stream);
    if (e != hipSuccess) fprintf(stderr, "cooperative launch failed: %s (grid %d)\n", hipGetErrorString(e), grid);
}
```

```cpp
#include <hip/hip_runtime.h>
#include <hip/hip_cooperative_groups.h>
#include <cstdio>
#include <cstdint>
namespace cg = cooperative_groups;

#define DI __device__ __forceinline__
#define LAS __attribute__((address_space(3)))
typedef unsigned short bf16_t;
typedef short bf16x8 __attribute__((ext_vector_type(8)));
typedef short s16x4 __attribute__((ext_vector_type(4)));
typedef short v4i16_t __attribute__((ext_vector_type(4)));
typedef float f32x4 __attribute__((ext_vector_type(4)));
typedef float f32x16 __attribute__((ext_vector_type(16)));
typedef unsigned u32x4 __attribute__((ext_vector_type(4)));
typedef unsigned u32x2 __attribute__((ext_vector_type(2)));
typedef float f32x2_t __attribute__((ext_vector_type(2)));
typedef __bf16 bf16x2_t __attribute__((ext_vector_type(2)));

constexpr int D = 1024, NB = 8, S = 2048, M = NB * S, DEPTH = 4, DFF = 2752, DFFP = 2816, NFF = 5632;
constexpr int EVC = 1720, EVCP = 1792, ODC = 3072;
constexpr float EPS = 1e-6f;
constexpr float L2E = 1.44269504088896f;

constexpr size_t MiB = 1u << 20;
constexpr size_t WS_CTL = 0, CTL_BYTES = 64 * 1024;
constexpr size_t WS_MOD = 1 * MiB;
constexpr size_t WS_ROPE = 3 * MiB;
constexpr size_t WS_LUT = 3 * MiB + 512 * 1024;
constexpr size_t WS_KMEAN = 3 * MiB + 768 * 1024;
constexpr size_t WS_WFI = 4 * MiB;
constexpr size_t WS_WFO = 92 * MiB;
constexpr size_t WS_WEI = 136 * MiB;
constexpr size_t WS_WEO = 143 * MiB;
constexpr size_t WS_WUQ = 147 * MiB;
constexpr size_t WS_WUKV = 148 * MiB;
constexpr size_t WS_WC1 = 149 * MiB;
constexpr size_t WS_WOI = 153 * MiB;
constexpr size_t WS_WOO = 165 * MiB;
constexpr size_t WS_Y = 168 * MiB;
constexpr size_t WS_H = 200 * MiB;
constexpr size_t WS_U = 288 * MiB;
constexpr size_t WS_CAT = 384 * MiB;
constexpr size_t WS_CQN = 416 * MiB;
constexpr size_t WS_CKVN = 424 * MiB;
constexpr size_t WS_KROPE = 428 * MiB;
constexpr size_t WS_NQ = 429 * MiB;
constexpr size_t WS_NKS = 445 * MiB;
constexpr size_t WS_NKW = 449 * MiB;
constexpr size_t WS_GT = 453 * MiB;
constexpr size_t WS_ACMP = 455 * MiB;
constexpr size_t WS_HID = 471 * MiB;
constexpr size_t WS_KCMP = 473 * MiB;
constexpr size_t WS_VCMP = 473 * MiB + 512 * 1024;
constexpr size_t WS_QFULL = 474 * MiB;
constexpr size_t WS_KVFULL = 498 * MiB;
constexpr size_t WS_QF = 530 * MiB;
constexpr size_t WS_KF = 554 * MiB;
constexpr size_t WS_NRM = 416 * MiB;
constexpr size_t WS_END = 578 * MiB;

constexpr int LDS_BYTES = 147456 + 256, LDS_MISC = 147456, CW_BAR = 8192;

DI unsigned f2bf(float f) { unsigned u = __builtin_bit_cast(unsigned, f); return (u + 0x7fffu + ((u >> 16) & 1u)) >> 16; }
DI unsigned pk2(float lo, float hi) { f32x2_t v = {lo, hi}; bf16x2_t b = __builtin_convertvector(v, bf16x2_t); return __builtin_bit_cast(unsigned, b); }
DI float bflo(unsigned w) { return __builtin_bit_cast(float, w << 16); }
DI float bfhi(unsigned w) { return __builtin_bit_cast(float, w & 0xffff0000u); }
DI float bf1(bf16_t b) { return __builtin_bit_cast(float, ((unsigned)b) << 16); }
DI float shx(float v, int mask) {
    int t = threadIdx.x; asm volatile("" : "+v"(t));
    return __builtin_bit_cast(float, __builtin_amdgcn_ds_bpermute(((t & 63) ^ mask) << 2, __builtin_bit_cast(int, v)));
}
DI float wave_sum(float v) {
#pragma unroll
    for (int o = 1; o < 64; o <<= 1) v += shx(v, o);
    return v;
}
DI float fsilu(float a) { return a / (1.f + __expf(-a)); }

namespace pg8 {
constexpr int BM = 256, BK = 64, HALF = 128, HTB = HALF * BK * 2, STAGE_BYTES = 8 * HTB, NXCD = 8, WGM = 8;
DI int lds_byte(int r, int c) { const int st = (r >> 4) * 2 + (c >> 5), rr = r & 15, cc = c & 31, ob = rr * 64 + cc * 2; return st * 1024 + (ob ^ (((ob >> 9) & 1) << 5)); }
DI void stage_rc(int b, int& R, int& C) { const int st = b / 1024, sb = b % 1024, swz = sb ^ (((sb >> 9) & 1) << 5); R = (st >> 1) * 16 + swz / 64; C = (st & 1) * 32 + (swz % 64) / 2; }
DI int perm32(int rho) { const int n = rho >> 4, i = rho & 15; return 8 * (i >> 2) + 4 * n + (i & 3); }
struct Unit { int pm, pn; };
struct Gemm { const bf16_t* A; const bf16_t* Bt; int M, N, K; };
struct StaticOrder {
    int nM, nN, nwg, G, c;
    DI void init(int M_, int N_, int G_, int c_) { nM = M_ / BM; nN = N_ / BM; nwg = nM * nN; G = G_; c = c_; }
    DI bool next(int i, Unit& u) const {
        const long L = (long)i * G + c; if (L >= nwg) return false;
        int wgid = (int)L; { const int q = nwg / NXCD, r = nwg % NXCD, xcd = wgid % NXCD, off = wgid / NXCD; wgid = (xcd < r ? xcd * (q + 1) : r * (q + 1) + (xcd - r) * q) + off; }
        const int nig = WGM * nN, gid = wgid / nig, fm = gid * WGM, gsz = (nM - fm) < WGM ? (nM - fm) : WGM;
        u.pm = fm + ((wgid % nig) % gsz); u.pn = (wgid % nig) / gsz; return true;
    }
    DI void a_ready(const Unit&) const {}
    DI void done(const Unit&) const {}
};

struct EpiBf16 {
    static constexpr bool PERM = true, AFTER_DRAIN = false;
    bf16_t* O; int ldc; int act;
    DI void operator()(const f32x4 (&acc)[2][2][4][2], const Unit& u, int wr, int wc, int fr, int fq) const {
        const int row0 = u.pm * BM + wr * 64 + fr, col0 = u.pn * BM + wc * 32 + 8 * fq;
#pragma unroll
        for (int ai = 0; ai < 2; ++ai)
#pragma unroll
            for (int m = 0; m < 4; ++m) { bf16_t* rowp = O + (size_t)(row0 + ai * HALF + m * 16) * ldc + col0;
#pragma unroll
                for (int bj = 0; bj < 2; ++bj) { f32x4 v0 = acc[ai][bj][m][0], v1 = acc[ai][bj][m][1];
                    if (act) { for (int e = 0; e < 4; ++e) { v0[e] = fsilu(v0[e]); v1[e] = fsilu(v1[e]); } }
                    u32x4 w; w.x = pk2(v0[0], v0[1]); w.y = pk2(v0[2], v0[3]); w.z = pk2(v1[0], v1[1]); w.w = pk2(v1[2], v1[3]);
                    *(u32x4*)(rowp + bj * HALF) = w; } }
    }
};
struct EpiSwiglu {
    static constexpr bool PERM = true, AFTER_DRAIN = false;
    bf16_t* H; int ldc;
    DI void operator()(const f32x4 (&acc)[2][2][4][2], const Unit& u, int wr, int wc, int fr, int fq) const {
        const int row0 = u.pm * BM + wr * 64 + fr, col0 = u.pn * HALF + wc * 32 + 8 * fq;
#pragma unroll
        for (int ai = 0; ai < 2; ++ai)
#pragma unroll
            for (int m = 0; m < 4; ++m) { bf16_t* rowp = H + (size_t)(row0 + ai * HALF + m * 16) * ldc + col0;
                f32x4 a0 = acc[ai][0][m][0], a1 = acc[ai][0][m][1], b0 = acc[ai][1][m][0], b1 = acc[ai][1][m][1];
#pragma unroll
                for (int e = 0; e < 4; ++e) { a0[e] = fsilu(a0[e]) * b0[e]; a1[e] = fsilu(a1[e]) * b1[e]; }
                u32x4 w; w.x = pk2(a0[0], a0[1]); w.y = pk2(a0[2], a0[3]); w.z = pk2(a1[0], a1[1]); w.w = pk2(a1[2], a1[3]);
                *(u32x4*)rowp = w; }
    }
};
struct EpiResid {
    static constexpr bool PERM = false, AFTER_DRAIN = false;
    const float* xin; float* xout; const float* gate; float gmul;
    DI void operator()(const f32x4 (&acc)[2][2][4][2], const Unit& u, int wr, int wc, int fr, int fq) const {
        const int row0 = u.pm * BM + wr * 64 + fr, col0 = u.pn * BM + wc * 32 + 4 * fq;
        const float* g = gate + (size_t)(u.pm >> 3) * 9216;
#pragma unroll
        for (int bj = 0; bj < 2; ++bj)
#pragma unroll
            for (int n = 0; n < 2; ++n) { const f32x4 gv = *(const f32x4*)(g + col0 + bj * HALF + n * 16) * gmul;
#pragma unroll
                for (int ai = 0; ai < 2; ++ai)
#pragma unroll
                    for (int m = 0; m < 4; ++m) { const size_t off = (size_t)(row0 + ai * HALF + m * 16) * D + col0 + bj * HALF + n * 16;
                        const f32x4 xi = *(const f32x4*)(xin + off); *(f32x4*)(xout + off) = xi + gv * acc[ai][bj][m][n]; } }
    }
};

template <class Epi, class Sched, bool ALIGN_EPI = false>
DI void gemm_phase(LAS unsigned char* lds, const Gemm g, const Sched& S_, const Epi& E) {
    int tid = threadIdx.x; asm volatile("" : "+v"(tid));
    const int wid = __builtin_amdgcn_readfirstlane(tid >> 6), lane = tid & 63, wr = wid >> 2, wc = wid & 3, fr = lane & 15, fq = lane >> 4;
    const int K = g.K, nt = K / BK;
    unsigned voffA[2], voffB[2];
#pragma unroll
    for (int i = 0; i < 2; ++i) { int R, C; stage_rc(tid * 16 + i * 8192, R, C); const int Rb = Epi::PERM ? ((R & ~31) + perm32(R & 31)) : R;
        voffA[i] = (unsigned)(R * K + C) * 2u; voffB[i] = (unsigned)(Rb * K + C) * 2u; }
    const size_t kstep = (size_t)(BK * 2);
    const size_t hstep = (size_t)HALF * K * 2;
    const size_t tstep = 2 * hstep;
    const unsigned ldsw = (unsigned)wid * 1024u;
    const int aoff = lds_byte(wr * 64 + fr, fq * 8), boff = lds_byte(wc * 32 + fr, fq * 8);
#define PG8_SA(b, h) (((b) * 2 + (h)) * HTB)
#define PG8_SB(b, h) ((4 + (b) * 2 + (h)) * HTB)
#define PG8_STAGE(bufoff, gbase, voff) do { _Pragma("unroll") for (int _i = 0; _i < 2; ++_i) \
        __builtin_amdgcn_global_load_lds((const unsigned*)((const char*)(gbase) + (voff)[_i]), (LAS unsigned*)(lds + (bufoff) + ldsw + _i * 8192), 16, 0, 0); } while (0)
#define PG8_LDA(dst, b, h) do { _Pragma("unroll") for (int m = 0; m < 4; ++m) _Pragma("unroll") for (int k = 0; k < 2; ++k) dst[m][k] = *(const LAS bf16x8*)(lds + PG8_SA(b, h) + aoff + m * 2048 + k * 1024); } while (0)
#define PG8_LDB(dst, b, h) do { _Pragma("unroll") for (int n = 0; n < 2; ++n) _Pragma("unroll") for (int k = 0; k < 2; ++k) dst[n][k] = *(const LAS bf16x8*)(lds + PG8_SB(b, h) + boff + n * 2048 + k * 1024); } while (0)
#define PG8_MMA(ai, bj, At, Bt) do { __builtin_amdgcn_s_setprio(1); _Pragma("unroll") for (int m = 0; m < 4; ++m) _Pragma("unroll") for (int n = 0; n < 2; ++n) _Pragma("unroll") for (int k = 0; k < 2; ++k) \
        acc[ai][bj][m][n] = __builtin_amdgcn_mfma_f32_16x16x32_bf16(Bt[n][k], At[m][k], acc[ai][bj][m][n], 0, 0, 0); __builtin_amdgcn_s_setprio(0); } while (0)
#define PG8_WAIT_V(n) asm volatile("s_waitcnt vmcnt(" #n ")" ::: "memory")
#define PG8_WAIT_L(n) asm volatile("s_waitcnt lgkmcnt(" #n ")" ::: "memory")
#define PG8_BAR __builtin_amdgcn_s_barrier()
#define PG8_SCHED __builtin_amdgcn_sched_barrier(0)
    Unit cur, nxt; int ui = 0;
    if (!S_.next(0, cur)) return;
    f32x4 acc[2][2][4][2];
#pragma unroll
    for (int a = 0; a < 2; ++a)
#pragma unroll
        for (int b = 0; b < 2; ++b)
#pragma unroll
            for (int m = 0; m < 4; ++m)
#pragma unroll
                for (int n = 0; n < 2; ++n) acc[a][b][m][n] = (f32x4){0.f, 0.f, 0.f, 0.f};
    bf16x8 At[4][2], B0[2][2], B1[2][2];
    const char* cA = (const char*)g.A + (size_t)cur.pm * tstep; const char* cB = (const char*)g.Bt + (size_t)cur.pn * tstep;
    PG8_STAGE(PG8_SB(0, 0), cB, voffB); PG8_STAGE(PG8_SB(0, 1), cB + hstep, voffB); PG8_STAGE(PG8_SA(0, 0), cA, voffA); PG8_STAGE(PG8_SA(0, 1), cA + hstep, voffA);
    if (wr == 1) PG8_BAR;
    PG8_WAIT_V(2); PG8_BAR;
    PG8_STAGE(PG8_SB(1, 0), cB + kstep, voffB); PG8_STAGE(PG8_SA(1, 0), cA + kstep, voffA); PG8_STAGE(PG8_SB(1, 1), cB + hstep + kstep, voffB);
    PG8_WAIT_V(6); PG8_BAR;
    for (;;) {
        const bool has_next = S_.next(ui + 1, nxt);
        const char* nA = has_next ? (const char*)g.A + (size_t)nxt.pm * tstep : cA; const char* nB = has_next ? (const char*)g.Bt + (size_t)nxt.pn * tstep : cB;
        for (int t = 0; t < nt; t += 2) {
            const bool last = (t == nt - 2);
            const char* a1 = cA + (size_t)(t + 1) * kstep;
            const char* a2 = last ? nA : cA + (size_t)(t + 2) * kstep; const char* b2 = last ? nB : cB + (size_t)(t + 2) * kstep;
            const char* a3 = a2 + kstep; const char* b3 = b2 + kstep;
            PG8_LDB(B0, 0, 0); PG8_LDB(B1, 0, 1); PG8_SCHED; PG8_LDA(At, 0, 0); PG8_STAGE(PG8_SA(1, 1), a1 + hstep, voffA);
            PG8_WAIT_V(8); PG8_WAIT_L(0); PG8_BAR; PG8_MMA(0, 0, At, B0); PG8_MMA(0, 1, At, B1); PG8_BAR; PG8_SCHED;
            PG8_LDA(At, 0, 1); PG8_STAGE(PG8_SB(0, 0), b2, voffB); PG8_STAGE(PG8_SB(0, 1), b2 + hstep, voffB); PG8_STAGE(PG8_SA(0, 0), a2, voffA);
            PG8_WAIT_V(8); PG8_WAIT_L(0); PG8_BAR; PG8_MMA(1, 0, At, B0); PG8_MMA(1, 1, At, B1); PG8_BAR; PG8_SCHED;
            PG8_LDB(B0, 1, 0); PG8_LDB(B1, 1, 1); PG8_SCHED; PG8_LDA(At, 1, 0); PG8_STAGE(PG8_SA(0, 1), a2 + hstep, voffA);
            PG8_WAIT_V(8); PG8_WAIT_L(0); PG8_BAR; PG8_MMA(0, 0, At, B0); PG8_MMA(0, 1, At, B1); PG8_BAR; PG8_SCHED;
            PG8_LDA(At, 1, 1); PG8_STAGE(PG8_SB(1, 0), b3, voffB); PG8_STAGE(PG8_SB(1, 1), b3 + hstep, voffB); PG8_STAGE(PG8_SA(1, 0), a3, voffA);
            PG8_WAIT_V(8); PG8_WAIT_L(0); PG8_BAR; PG8_MMA(1, 0, At, B0); PG8_MMA(1, 1, At, B1); PG8_BAR; PG8_SCHED;
        }
        if constexpr (ALIGN_EPI) { if (wr == 0) PG8_BAR; }
        E(acc, cur, wr, wc, fr, fq);
        if (!has_next) break;
#pragma unroll
        for (int a = 0; a < 2; ++a)
#pragma unroll
            for (int b = 0; b < 2; ++b)
#pragma unroll
                for (int m = 0; m < 4; ++m)
#pragma unroll
                    for (int n = 0; n < 2; ++n) acc[a][b][m][n] = (f32x4){0.f, 0.f, 0.f, 0.f};
        cur = nxt; cA = nA; cB = nB; ++ui;
        if constexpr (ALIGN_EPI) { if (wr == 1) PG8_BAR; }
    }
    PG8_WAIT_V(0);
    if constexpr (!ALIGN_EPI) { if (wr == 0) PG8_BAR; }
    PG8_BAR;
#undef PG8_SA
#undef PG8_SB
#undef PG8_STAGE
#undef PG8_LDA
#undef PG8_LDB
#undef PG8_MMA
#undef PG8_WAIT_V
#undef PG8_WAIT_L
#undef PG8_BAR
#undef PG8_SCHED
}
}

constexpr int WL_BYTES = 18432, WL_LUT = 0, WL_K = 640, WL_IMP = 9856, VROWB = 144;
DI int crow(int i, int h) { return (i & 3) + 8 * (i >> 2) + 4 * h; }
DI s16x4 vtr(const LAS char* p) { return __builtin_bit_cast(s16x4, __builtin_amdgcn_ds_read_tr16_b64_v4i16((LAS v4i16_t*)p)); }
#define MFMA32(a, b, c) __builtin_amdgcn_mfma_f32_32x32x16_bf16((a), (b), (c), 0, 0, 0)

template <int DK> struct KVRegs { u32x4 k[DK / 16]; u32x4 v[4]; };

template <int DK>
DI void kv_load(KVRegs<DK>& R, const bf16_t* __restrict__ Kb, int kstride, const bf16_t* __restrict__ Vb, int vstride, int krow0, int krstep, int i0, int nkeys, int lane) {
    constexpr int CPR = DK / 8;
#pragma unroll
    for (int c = 0; c < DK / 16; ++c) { const int ch = c * 64 + lane, row = ch / CPR, cc = ch % CPR; int idx = i0 + row; idx = idx < nkeys ? idx : nkeys - 1;
        R.k[c] = *(const u32x4*)(Kb + (size_t)(krow0 + krstep * idx) * kstride + cc * 8); }
    if (Vb) {
#pragma unroll
        for (int c = 0; c < 4; ++c) { const int ch = c * 64 + lane, row = ch >> 3, cc = ch & 7; int idx = i0 + row; idx = idx < nkeys ? idx : nkeys - 1;
            R.v[c] = *(const u32x4*)(Vb + (size_t)(krow0 + krstep * idx) * vstride + cc * 8); }
    }
}
template <int DK>
DI void kv_stage(const KVRegs<DK>& R, LAS char* wl, bool hasv, int lane) {
    constexpr int CPR = DK / 8, KROWB = DK * 2 + 16;
#pragma unroll
    for (int c = 0; c < DK / 16; ++c) { const int ch = c * 64 + lane, row = ch / CPR, cc = ch % CPR; *(LAS u32x4*)(wl + WL_K + row * KROWB + cc * 16) = R.k[c]; }
    if (hasv) {
#pragma unroll
        for (int c = 0; c < 4; ++c) { const int ch = c * 64 + lane, row = ch >> 3, cc = ch & 7; *(LAS u32x4*)(wl + WL_K + 32 * KROWB + row * VROWB + cc * 16) = R.v[c]; }
    }
}
template <int DK>
DI void qk_tile(f32x16& Sx, const LAS char* wl, const bf16x8 (&qf)[DK / 16], int i0, int nkeys, int kpos0, int kpstep, int qpos, int W,
                unsigned selmask, int blkshift, bool usesel, bool uselut, float sc, int lane) {
    constexpr int KROWB = DK * 2 + 16;
    const int r = lane & 31, h = lane >> 5;
#pragma unroll
    for (int i = 0; i < 16; ++i) Sx[i] = 0.f;
#pragma unroll
    for (int ks = 0; ks < DK / 16; ++ks) { const bf16x8 kf = *(const LAS bf16x8*)(wl + WL_K + r * KROWB + ks * 32 + h * 16); Sx = MFMA32(kf, qf[ks], Sx); }
    const LAS float* lut = (const LAS float*)(wl + WL_LUT);
#pragma unroll
    for (int i = 0; i < 16; ++i) {
        const int idx = i0 + crow(i, h), kpos = kpos0 + kpstep * idx, dist = qpos - kpos;
        bool valid = (idx < nkeys) && (dist >= 0) && (dist <= W);
        if (usesel) valid = valid && ((selmask >> ((kpos >> blkshift) & 31)) & 1u);
        float bias = 0.f;
        if (uselut) { int di = dist < 0 ? 0 : (dist > 128 ? 128 : dist); bias = lut[di]; }
        Sx[i] = valid ? Sx[i] * sc + bias : -1e30f;
    }
}

template <int DK>
DI void attn_core(LAS char* wl, const bf16x8 (&qf)[DK / 16], const bf16_t* __restrict__ Kb, int kstride, const bf16_t* __restrict__ Vb, int vstride,
                  int krow0, int krstep, int kpos0, int kpstep, int i_lo, int i_hi, int nkeys, int qpos, int W,
                  unsigned selmask, int blkshift, bool usesel, bool uselut, float sc, f32x16 (&O)[2], float& m, float& l, int lane_in) {
    int lane = lane_in; asm volatile("" : "+v"(lane));
    const int h = lane >> 5;
#define ATT_ADV(iv) while ((iv) < i_hi && usesel && __ballot(((selmask >> (((kpos0 + kpstep * (iv)) >> blkshift) & 31)) & 1u) != 0) == 0ull) (iv) += 32;
    int i0 = i_lo; ATT_ADV(i0);
    if (i0 >= i_hi) return;
    KVRegs<DK> R;
    kv_load<DK>(R, Kb, kstride, Vb, vstride, krow0, krstep, i0, nkeys, lane);
    const int q4 = (lane & 15) >> 2, p4 = lane & 3, blk = (lane >> 4) & 1;
    const LAS char* vbase = wl + WL_K + 32 * (DK * 2 + 16) + (4 * h + q4) * VROWB + blk * 32 + p4 * 8;
    for (;;) {
        kv_stage<DK>(R, wl, true, lane);
        int inext = i0 + 32; ATT_ADV(inext);
        if (inext < i_hi) kv_load<DK>(R, Kb, kstride, Vb, vstride, krow0, krstep, inext, nkeys, lane);
        f32x16 Sx;
        qk_tile<DK>(Sx, wl, qf, i0, nkeys, kpos0, kpstep, qpos, W, selmask, blkshift, usesel, uselut, sc, lane);
        float tmax = Sx[0];
#pragma unroll
        for (int i = 1; i < 16; ++i) tmax = fmaxf(tmax, Sx[i]);
        tmax = fmaxf(tmax, shx(tmax, 32));
        const float mnew = fmaxf(m, tmax), alpha = __builtin_amdgcn_exp2f(m - mnew);
        m = mnew;
        float psum = 0.f;
#pragma unroll
        for (int i = 0; i < 16; ++i) { const float p = Sx[i] > -5e29f ? __builtin_amdgcn_exp2f(Sx[i] - mnew) : 0.f; Sx[i] = p; psum += p; }
        l = l * alpha + psum;
#pragma unroll
        for (int i = 0; i < 16; ++i) { O[0][i] *= alpha; O[1][i] *= alpha; }
#pragma unroll
        for (int s = 0; s < 2; ++s) {
            u32x4 pw; pw.x = pk2(Sx[8 * s], Sx[8 * s + 1]); pw.y = pk2(Sx[8 * s + 2], Sx[8 * s + 3]); pw.z = pk2(Sx[8 * s + 4], Sx[8 * s + 5]); pw.w = pk2(Sx[8 * s + 6], Sx[8 * s + 7]);
            const bf16x8 pb = __builtin_bit_cast(bf16x8, pw);
#pragma unroll
            for (int db = 0; db < 2; ++db) {
                const s16x4 lo = vtr(vbase + (16 * s) * VROWB + db * 64), hi = vtr(vbase + (16 * s + 8) * VROWB + db * 64);
                const bf16x8 va = __builtin_shufflevector(lo, hi, 0, 1, 2, 3, 4, 5, 6, 7);
                O[db] = MFMA32(va, pb, O[db]);
            }
        }
        if (inext >= i_hi) break;
        i0 = inext;
    }
#undef ATT_ADV
}
DI void o_zero(f32x16 (&O)[2]) {
#pragma unroll
    for (int i = 0; i < 16; ++i) { O[0][i] = 0.f; O[1][i] = 0.f; }
}
DI void o_store(bf16_t* outp, const f32x16 (&O)[2], float scale, int h) {
#pragma unroll
    for (int db = 0; db < 2; ++db)
#pragma unroll
        for (int g4 = 0; g4 < 4; ++g4) { u32x2 w; w.x = pk2(O[db][4 * g4] * scale, O[db][4 * g4 + 1] * scale); w.y = pk2(O[db][4 * g4 + 2] * scale, O[db][4 * g4 + 3] * scale);
            *(u32x2*)(outp + 32 * db + 8 * g4 + 4 * h) = w; }
}
DI void lut_write(LAS char* wl, const float* lutg, int slot, int lane) {
    LAS float* lut = (LAS float*)(wl + WL_LUT);
    for (int i = lane; i < 132; i += 64) lut[i] = lutg[slot * 132 + i];
}
template <int NQ>
DI void q_load(bf16x8 (&qf)[NQ], const bf16_t* qrow, int h) {
#pragma unroll
    for (int ks = 0; ks < NQ; ++ks) qf[ks] = *(const bf16x8*)(qrow + ks * 16 + h * 8);
}

struct Args {
    const float* in[23]; float* out; unsigned char* ws; int ph_lo, ph_hi;
};

struct Ctx {
    const float* const* in; float* out; unsigned char* ws; LAS unsigned char* lds;
    int tid, lane, wave, gw, NGW, G;
};

DI int colmap(int mode, int np, int N) {
    if (mode == 0) return np < N ? np : -1;
    const int t = np >> 8, rr = np & 255, bj = rr >> 7, jj = rr & 127, j = t * 128 + jj;
    return j < DFF ? bj * DFF + j : -1;
}
DI void transpose_item(const float* __restrict__ W, int K, int N, bf16_t* __restrict__ Wt, int Np, int Kp, int mode, LAS float* scr, int item, int lane) {
    const int nblk = Np / 32, kb = item / nblk, nb = item % nblk, k0 = 64 * kb, n0 = 32 * nb;
    const int sc = colmap(mode, n0 + (lane & 31), N);
#pragma unroll 8
    for (int i = 0; i < 32; ++i) { const int kk = 2 * i + (lane >> 5), k = k0 + kk; float v = 0.f; if (sc >= 0 && k < K) v = W[(size_t)k * N + sc]; scr[kk * 33 + (lane & 31)] = v; }
    asm volatile("s_waitcnt lgkmcnt(0)" ::: "memory");
    const int c = lane & 7;
#pragma unroll
    for (int j = 0; j < 4; ++j) { const int n = (lane >> 3) + 8 * j; const LAS float* s = scr + (8 * c) * 33 + n;
        u32x4 o; o.x = pk2(s[0 * 33], s[1 * 33]); o.y = pk2(s[2 * 33], s[3 * 33]); o.z = pk2(s[4 * 33], s[5 * 33]); o.w = pk2(s[6 * 33], s[7 * 33]);
        *(u32x4*)(Wt + (size_t)(n0 + n) * Kp + k0 + 8 * c) = o; }
    asm volatile("s_waitcnt lgkmcnt(0)" ::: "memory");
}
#define TR_SET(src, dstoff, nmat, K_, N_, Np_, Kp_, mode_) { const int per = ((Kp_) / 64) * ((Np_) / 32), tot = (nmat) * per; \
    if (r < tot) { const int mi = r / per, it = r % per; transpose_item((src) + (size_t)mi * (K_) * (N_), (K_), (N_), (bf16_t*)(C.ws + (dstoff)) + (size_t)mi * (Np_) * (Kp_), (Np_), (Kp_), (mode_), scr, it, C.lane); continue; } r -= tot; }

DI void prologue(const Ctx& C) {
    LAS float* cact = (LAS float*)C.lds;
    const float* cin = C.in[1];
    for (int i = C.tid; i < NB * D; i += 512) cact[i] = fsilu(cin[i]);
    __syncthreads();
    {
        const float* adaw = C.in[3]; const float* adab = C.in[4]; float* mod = (float*)(C.ws + WS_MOD);
        for (int unit = C.gw; unit < DEPTH * 144; unit += C.NGW) {
            const int layer = unit / 144, n = (unit % 144) * 64 + C.lane;
            const float* w = adaw + (size_t)layer * D * 9216 + n;
            float acc[8];
#pragma unroll
            for (int b = 0; b < 8; ++b) acc[b] = 0.f;
            for (int k = 0; k < D; k += 4) {
                float wv[4];
#pragma unroll
                for (int j = 0; j < 4; ++j) wv[j] = w[(size_t)(k + j) * 9216];
#pragma unroll
                for (int b = 0; b < 8; ++b) { const f32x4 cv = *(const LAS f32x4*)(cact + b * D + k); acc[b] += cv[0] * wv[0] + cv[1] * wv[1] + cv[2] * wv[2] + cv[3] * wv[3]; }
            }
            const float bias = adab[layer * 9216 + n];
#pragma unroll
            for (int b = 0; b < 8; ++b) mod[((size_t)layer * 8 + b) * 9216 + n] = acc[b] + bias;
        }
    }
    {
        float* rope = (float*)(C.ws + WS_ROPE); float* lut = (float*)(C.ws + WS_LUT); const float* t5 = C.in[2];
        const int gt = C.gw * 64 + C.lane, NT = C.NGW * 64;
        for (int i = gt; i < S * 16; i += NT) {
            const int pos = i >> 4, j = i & 15;
            const float inv = exp2f(-(float)j * (1.f / 16.f) * 13.287712379549449f);
            const float ang = (float)pos * inv;
            const double rev = (double)ang * 0.15915494309189535; const double fr = rev - rint(rev);
            rope[2 * i] = __builtin_amdgcn_cosf((float)fr); rope[2 * i + 1] = __builtin_amdgcn_sinf((float)fr);
        }
        for (int i = gt; i < 16 * 132; i += NT) {
            const int slot = i / 132, d = i % 132; const int n = d > 128 ? 128 : d;
            int bucket;
            if (n < 16) bucket = n; else { const float nf = (float)n; int lg = 16 + (int)(logf(nf / 16.f) / 2.0794415416798357f * 16.f); bucket = lg < 31 ? lg : 31; }
            lut[i] = t5[bucket * 16 + slot] * L2E;
        }
    }
    {
        LAS float* scr = (LAS float*)(C.lds + 32768 + C.wave * 8704);
        constexpr int TOT = 8 * 16 * 176 + 8 * 44 * 32 + 2 * 16 * 56 + 2 * 16 * 32 + 2 * 4 * 24 + 2 * 2 * 32 + 4 * 32 * 8 + 2 * 16 * 96 + 2 * 8 * 32;
        for (int it0 = C.gw; it0 < TOT; it0 += C.NGW) {
            int r = it0;
            TR_SET(C.in[6], WS_WFI, 8, D, 2 * DFF, NFF, D, 1)
            TR_SET(C.in[7], WS_WFO, 8, DFF, D, D, DFFP, 0)
            TR_SET(C.in[8], WS_WEI, 2, D, EVC, EVCP, D, 0)
            TR_SET(C.in[9], WS_WEO, 2, D, D, D, D, 0)
            TR_SET(C.in[12], WS_WUQ, 2, 256, 768, 768, 256, 0)
            TR_SET(C.in[13], WS_WUKV, 2, 128, 1024, 1024, 128, 0)
            TR_SET(C.in[16], WS_WC1, 4, 2048, 256, 256, 2048, 0)
            TR_SET(C.in[19], WS_WOI, 2, D, ODC, ODC, D, 0)
            TR_SET(C.in[20], WS_WOO, 2, 512, D, D, 512, 0)
        }
    }
}

DI void norm_phase(const Ctx& C, const float* xsrc, int layer, int sub) {
    const float* g = C.in[5] + (size_t)(layer * 3 + sub) * D;
    const float* mod = (const float*)(C.ws + WS_MOD) + (size_t)layer * 8 * 9216 + sub * 3072;
    bf16_t* Y = (bf16_t*)(C.ws + WS_Y);
    for (int row = C.gw; row < M; row += C.NGW) {
        const f32x4* xr = (const f32x4*)(xsrc + (size_t)row * D) + C.lane;
        f32x4 v[4]; float ss = 0.f;
#pragma unroll
        for (int j = 0; j < 4; ++j) { v[j] = xr[64 * j]; ss += v[j][0] * v[j][0] + v[j][1] * v[j][1] + v[j][2] * v[j][2] + v[j][3] * v[j][3]; }
        const float rinv = rsqrtf(wave_sum(ss) * (1.f / D) + EPS);
        const float* mb = mod + (size_t)(row >> 11) * 9216;
        u32x2* o = (u32x2*)(Y + (size_t)row * D) + C.lane;
#pragma unroll
        for (int j = 0; j < 4; ++j) { const int c = 4 * C.lane + 256 * j;
            const f32x4 gv = *(const f32x4*)(g + c), sh = *(const f32x4*)(mb + c), scl = *(const f32x4*)(mb + 1024 + c);
            f32x4 y; for (int e = 0; e < 4; ++e) y[e] = v[j][e] * rinv * gv[e] * (1.f + scl[e]) + sh[e];
            u32x2 w; w.x = pk2(y[0], y[1]); w.y = pk2(y[2], y[3]); o[64 * j] = w; }
    }
}

DI void norm64_8(const bf16_t* src, bf16_t* dst, const float* g, int lane, bool active) {
    u32x4 w = {0u, 0u, 0u, 0u};
    if (active) w = *(const u32x4*)src;
    float v[8] = {bflo(w.x), bfhi(w.x), bflo(w.y), bfhi(w.y), bflo(w.z), bfhi(w.z), bflo(w.w), bfhi(w.w)};
    float ss = 0.f;
#pragma unroll
    for (int e = 0; e < 8; ++e) ss += v[e] * v[e];
    ss += shx(ss, 1); ss += shx(ss, 2); ss += shx(ss, 4);
    const float rinv = rsqrtf(ss * (1.f / 64.f) + EPS);
    if (active) { const float* gg = g + 8 * (lane & 7);
        u32x4 o; o.x = pk2(v[0] * rinv * gg[0], v[1] * rinv * gg[1]); o.y = pk2(v[2] * rinv * gg[2], v[3] * rinv * gg[3]);
        o.z = pk2(v[4] * rinv * gg[4], v[5] * rinv * gg[5]); o.w = pk2(v[6] * rinv * gg[6], v[7] * rinv * gg[7]);
        *(u32x4*)dst = o; }
}

DI void epost1(const Ctx& C, int j) {
    const bf16_t* U = (const bf16_t*)(C.ws + WS_U);
    bf16_t* CQN = (bf16_t*)(C.ws + WS_CQN); bf16_t* CKVN = (bf16_t*)(C.ws + WS_CKVN); bf16_t* KROPE = (bf16_t*)(C.ws + WS_KROPE);
    bf16_t* NQ = (bf16_t*)(C.ws + WS_NQ); bf16_t* NKS = (bf16_t*)(C.ws + WS_NKS); bf16_t* NKW = (bf16_t*)(C.ws + WS_NKW);
    float* GT = (float*)(C.ws + WS_GT); bf16_t* ACMP = (bf16_t*)(C.ws + WS_ACMP);
    const float* rope = (const float*)(C.ws + WS_ROPE);
    const float* qng = C.in[10] + j * 256; const float* kvng = C.in[11] + j * 128; const float* mqk = C.in[14] + j * 192;
    const float* pe = C.in[15] + (size_t)j * 2 * 32 * 64; const float* nqk = C.in[18] + j * 128;
    const int lane = C.lane;
    for (int row = C.gw; row < M; row += C.NGW) {
        const int b = row >> 11, t = row & 2047;
        const bf16_t* ur = U + (size_t)row * EVCP;
        {
            const u32x2 w = *(const u32x2*)(ur + 4 * lane);
            float v[4] = {bflo(w.x), bfhi(w.x), bflo(w.y), bfhi(w.y)};
            const float ss = wave_sum(v[0] * v[0] + v[1] * v[1] + v[2] * v[2] + v[3] * v[3]);
            const float rinv = rsqrtf(ss * (1.f / 256.f) + EPS); const f32x4 g = *(const f32x4*)(qng + 4 * lane);
            u32x2 o; o.x = pk2(v[0] * rinv * g[0], v[1] * rinv * g[1]); o.y = pk2(v[2] * rinv * g[2], v[3] * rinv * g[3]);
            *(u32x2*)(CQN + (size_t)row * 256 + 4 * lane) = o;
        }
        {
            const unsigned w = *(const unsigned*)(ur + 256 + 2 * lane);
            const float v0 = bflo(w), v1 = bfhi(w);
            const float ss = wave_sum(v0 * v0 + v1 * v1);
            const float rinv = rsqrtf(ss * (1.f / 128.f) + EPS);
            *(unsigned*)(CKVN + (size_t)row * 128 + 2 * lane) = pk2(v0 * rinv * kvng[2 * lane], v1 * rinv * kvng[2 * lane + 1]);
        }
        {
            const float v = lane < 32 ? bf1(ur[384 + lane]) : 0.f;
            const float ss = wave_sum(v * v);
            const float rinv = rsqrtf(ss * (1.f / 32.f) + EPS);
            const float vn = v * rinv * mqk[96 + 64 + (lane & 31)];
            const float pt = shx(vn, 16);
            const int i = lane & 15; const float cs = rope[(t * 16 + i) * 2], sn = rope[(t * 16 + i) * 2 + 1];
            const float o = (lane < 16) ? vn * cs - pt * sn : vn * cs + pt * sn;
            if (lane < 32) KROPE[(size_t)row * 32 + lane] = (bf16_t)f2bf(o);
        }
        norm64_8(ur + 416 + 8 * lane, NQ + (size_t)row * 512 + 8 * lane, nqk, lane, true);
        {
#pragma unroll
            for (int which = 0; which < 2; ++which) {
                const unsigned w = *(const unsigned*)(ur + (which ? 1440 : 1184) + 2 * lane);
                const float v0 = bflo(w), v1 = bfhi(w); float ss = v0 * v0 + v1 * v1;
                ss += shx(ss, 1); ss += shx(ss, 2); ss += shx(ss, 4); ss += shx(ss, 8); ss += shx(ss, 16);
                const float rinv = rsqrtf(ss * (1.f / 64.f) + EPS); const int d = 2 * (lane & 31);
                *(unsigned*)((which ? NKW : NKS) + (size_t)row * 128 + 2 * lane) = pk2(v0 * rinv * nqk[64 + d], v1 * rinv * nqk[64 + d + 1]);
            }
        }
        {
            const int n1 = t >> 4, l1 = t & 15, g = lane >> 5, d = 2 * (lane & 31);
#pragma unroll
            for (int kind = 0; kind < 2; ++kind) {
                const unsigned w = *(const unsigned*)(ur + 928 + kind * 128 + 2 * lane);
                const float v0 = bflo(w), v1 = bfhi(w);
                bf16_t* A = ACMP + (size_t)kind * 2048 * 2048;
                const float* pk = pe + kind * 2048;
                if (n1 <= 126) { const size_t ra = (size_t)((b * 127 + n1) * 2 + g); *(unsigned*)(A + ra * 2048 + l1 * 64 + d) = pk2(v0 + pk[l1 * 64 + d], v1 + pk[l1 * 64 + d + 1]); }
                if (n1 >= 1) { const int l2 = l1 + 16; const size_t ra = (size_t)((b * 127 + n1 - 1) * 2 + g); *(unsigned*)(A + ra * 2048 + l2 * 64 + d) = pk2(v0 + pk[l2 * 64 + d], v1 + pk[l2 * 64 + d + 1]); }
            }
        }
        if (lane < 24) { const float x = bf1(ur[1696 + lane]); GT[(size_t)row * 24 + lane] = 1.f / (1.f + __expf(-x)); }
    }
}

DI void epost2(const Ctx& C, int j) {
    const bf16_t* QFULL = (const bf16_t*)(C.ws + WS_QFULL); const bf16_t* KVFULL = (const bf16_t*)(C.ws + WS_KVFULL);
    const bf16_t* KROPE = (const bf16_t*)(C.ws + WS_KROPE);
    bf16_t* QF = (bf16_t*)(C.ws + WS_QF); bf16_t* KF = (bf16_t*)(C.ws + WS_KF);
    const float* rope = (const float*)(C.ws + WS_ROPE);
    const float* mqk = C.in[14] + j * 192; const float* nqk = C.in[18] + j * 128;
    const int lane = C.lane, head = lane >> 3, c = lane & 7;
    for (int row = C.gw; row < M; row += C.NGW) {
        const int t = row & 2047;
        const bf16_t* qr = QFULL + (size_t)row * 768 + head * 96; const bf16_t* kvr = KVFULL + (size_t)row * 1024 + head * 128;
        bf16_t* qo = QF + (size_t)row * 768 + head * 96; bf16_t* ko = KF + (size_t)row * 768 + head * 96;
        norm64_8(qr + 8 * c, qo + 8 * c, mqk, lane, true);
        norm64_8(kvr + 8 * c, ko + 8 * c, mqk + 96, lane, true);
        {
            const u32x2 w = *(const u32x2*)(qr + 64 + 4 * c);
            float v[4] = {bflo(w.x), bfhi(w.x), bflo(w.y), bfhi(w.y)};
            float ss = v[0] * v[0] + v[1] * v[1] + v[2] * v[2] + v[3] * v[3];
            ss += shx(ss, 1); ss += shx(ss, 2); ss += shx(ss, 4);
            const float rinv = rsqrtf(ss * (1.f / 32.f) + EPS);
            float o[4];
#pragma unroll
            for (int e = 0; e < 4; ++e) {
                const float vn = v[e] * rinv * mqk[64 + 4 * c + e];
                const float pt = shx(vn, 4);
                const int i = 4 * (c & 3) + e; const float cs = rope[(t * 16 + i) * 2], sn = rope[(t * 16 + i) * 2 + 1];
                o[e] = (c < 4) ? vn * cs - pt * sn : vn * cs + pt * sn;
            }
            u32x2 ow; ow.x = pk2(o[0], o[1]); ow.y = pk2(o[2], o[3]);
            *(u32x2*)(qo + 64 + 4 * c) = ow;
        }
        *(u32x2*)(ko + 64 + 4 * c) = *(const u32x2*)(KROPE + (size_t)row * 32 + 4 * c);
    }
    const bf16_t* HID = (const bf16_t*)(C.ws + WS_HID); bf16_t* KCMP = (bf16_t*)(C.ws + WS_KCMP); bf16_t* VCMP = (bf16_t*)(C.ws + WS_VCMP);
    const float* w2 = C.in[17] + (size_t)j * 2 * 256 * 64;
    for (int unit = C.gw; unit < 2 * 2032; unit += C.NGW) {
        const int kind = unit / 2032, rc = unit % 2032;
        const u32x2 hw = *(const u32x2*)(HID + (size_t)kind * 2048 * 256 + (size_t)rc * 256 + 4 * lane);
        const float hv[4] = {bflo(hw.x), bfhi(hw.x), bflo(hw.y), bfhi(hw.y)};
        const float* w = w2 + kind * 256 * 64 + lane;
        float acc = 0.f;
#pragma unroll 8
        for (int jj = 0; jj < 64; ++jj) {
#pragma unroll
            for (int e = 0; e < 4; ++e) acc += __builtin_bit_cast(float, __builtin_amdgcn_readlane(__builtin_bit_cast(int, hv[e]), jj)) * w[(4 * jj + e) * 64];
        }
        if (kind == 0) { const float ss = wave_sum(acc * acc); acc = acc * rsqrtf(ss * (1.f / 64.f) + EPS) * nqk[64 + lane]; KCMP[(size_t)rc * 64 + lane] = (bf16_t)f2bf(acc); }
        else VCMP[(size_t)rc * 64 + lane] = (bf16_t)f2bf(acc);
    }
}

DI void opost(const Ctx& C, int j) {
    const bf16_t* U = (const bf16_t*)(C.ws + WS_U); bf16_t* NRM = (bf16_t*)(C.ws + WS_NRM);
    const float* dg = C.in[21] + j * 128; const float* mg = C.in[22] + j * 128;
    const int lane = C.lane, hf = lane >> 5, l5 = lane & 31;
    for (int row = C.gw; row < M; row += C.NGW) {
        const bf16_t* ur = U + (size_t)row * ODC; bf16_t* nr = NRM + (size_t)row * 2048;
        norm64_8(ur + 8 * lane, nr + 8 * lane, dg, lane, true);
        norm64_8(ur + 768 + 8 * lane, nr + 768 + 8 * lane, dg + 64, lane, true);
        norm64_8(ur + hf * 768 + 512 + 8 * l5, nr + hf * 768 + 512 + 8 * l5, dg + hf * 64, lane, true);
        norm64_8(ur + 2304 + hf * 256 + 8 * l5, nr + 1536 + hf * 256 + 8 * l5, mg + hf * 64, lane, true);
    }
    float* KM = (float*)(C.ws + WS_KMEAN);
    if (C.wave == 0) {
        for (int unit = blockIdx.x; unit < 256; unit += C.G) {
            const int b = unit >> 5, hh = (unit >> 3) & 3, blk = unit & 7;
            const bf16_t* kp = U + (size_t)(b * S + blk * 256) * ODC + 2560 + hh * 64 + lane;
            const float g = mg[64 + lane]; float acc = 0.f;
            for (int i = 0; i < 256; ++i) { const float v = bf1(kp[(size_t)i * ODC]); const float ss = wave_sum(v * v); acc += v * rsqrtf(ss * (1.f / 64.f) + EPS) * g; }
            KM[unit * 64 + lane] = acc * (1.f / 256.f);
        }
    }
}

DI int next_item(unsigned* ctr, int lane) {
    int it = 0;
    if (lane == 0) it = (int)__hip_atomic_fetch_add(ctr, 1u, __ATOMIC_RELAXED, __HIP_MEMORY_SCOPE_AGENT);
    return __builtin_amdgcn_readfirstlane(it);
}

DI void eattn(const Ctx& C, unsigned* ctr) {
    LAS char* wl = (LAS char*)C.lds + C.wave * WL_BYTES;
    const int lane = C.lane, r = lane & 31, h = lane >> 5;
    const bf16_t* U = (const bf16_t*)(C.ws + WS_U); const bf16_t* NQ = (const bf16_t*)(C.ws + WS_NQ);
    const bf16_t* NKS = (const bf16_t*)(C.ws + WS_NKS); const bf16_t* NKW = (const bf16_t*)(C.ws + WS_NKW);
    const bf16_t* KCMP = (const bf16_t*)(C.ws + WS_KCMP); const bf16_t* VCMP = (const bf16_t*)(C.ws + WS_VCMP);
    const bf16_t* QF = (const bf16_t*)(C.ws + WS_QF); const bf16_t* KF = (const bf16_t*)(C.ws + WS_KF); const bf16_t* KVFULL = (const bf16_t*)(C.ws + WS_KVFULL);
    const float* GT = (const float*)(C.ws + WS_GT); const float* lutg = (const float*)(C.ws + WS_LUT);
    bf16_t* CAT = (bf16_t*)(C.ws + WS_CAT);
    const float sc64 = 0.125f * L2E, sc96 = 0.10206207261596575f * L2E;
    constexpr int NNSA = 1024, NMLA = 4096, BIG = 1 << 20;
    for (;;) {
        const int it = next_item(ctr, lane);
        if (it >= NNSA + NMLA) break;
        if (it < NNSA) {
            const int qt = 63 - (it >> 4), b = (it >> 1) & 7, g = it & 1;
            const int qs = qt * 32, tok = b * S + qs + r, qpos = qs + r;
            LAS float* imp = (LAS float*)(wl + WL_IMP);
            for (int i = lane; i < 32 * 33; i += 64) imp[i] = 0.f;
            const bf16_t* kc = KCMP + (size_t)(b * 127 * 2 + g) * 64; const bf16_t* vc = VCMP + (size_t)(b * 127 * 2 + g) * 64;
            for (int p = 0; p < 4; ++p) {
                lut_write(wl, lutg, 8 + g * 4 + p, lane);
                bf16x8 qf[4]; q_load<4>(qf, NQ + (size_t)tok * 512 + (g * 4 + p) * 64, h);
                float mx = -1e30f, sum = 0.f;
                for (int tt = 0; tt < 4; ++tt) {
                    KVRegs<64> R; kv_load<64>(R, kc, 128, nullptr, 0, 0, 1, 32 * tt, 127, lane);
                    kv_stage<64>(R, wl, false, lane);
                    f32x16 Sx;
                    qk_tile<64>(Sx, wl, qf, 32 * tt, 127, 31, 16, qpos, BIG, 0u, 0, false, true, sc64, lane);
                    float tm = Sx[0];
#pragma unroll
                    for (int i = 1; i < 16; ++i) tm = fmaxf(tm, Sx[i]);
                    tm = fmaxf(tm, shx(tm, 32));
                    const float mn = fmaxf(mx, tm); sum *= __builtin_amdgcn_exp2f(mx - mn); mx = mn;
#pragma unroll
                    for (int i = 0; i < 16; ++i) sum += Sx[i] > -5e29f ? __builtin_amdgcn_exp2f(Sx[i] - mn) : 0.f;
                }
                sum += shx(sum, 32);
                const float inv = 1.f / fmaxf(sum, 1e-30f);
                for (int tt = 0; tt < 4; ++tt) {
                    KVRegs<64> R; kv_load<64>(R, kc, 128, nullptr, 0, 0, 1, 32 * tt, 127, lane);
                    kv_stage<64>(R, wl, false, lane);
                    f32x16 Sx;
                    qk_tile<64>(Sx, wl, qf, 32 * tt, 127, 31, 16, qpos, BIG, 0u, 0, false, true, sc64, lane);
#pragma unroll
                    for (int i = 0; i < 16; ++i) Sx[i] = Sx[i] > -5e29f ? __builtin_amdgcn_exp2f(Sx[i] - mx) * inv : 0.f;
#pragma unroll
                    for (int g4 = 0; g4 < 4; ++g4) { const int mb = 8 * tt + 2 * g4 + h;
                        imp[r * 33 + mb] += Sx[4 * g4] + Sx[4 * g4 + 1] + Sx[4 * g4 + 2] + 0.5f * Sx[4 * g4 + 3]; }
                    asm volatile("s_waitcnt lgkmcnt(0)" ::: "memory");
#pragma unroll
                    for (int g4 = 0; g4 < 4; ++g4) { const int mb = 8 * tt + 2 * g4 + h + 1;
                        imp[r * 33 + mb] += 0.5f * Sx[4 * g4 + 3]; }
                    asm volatile("s_waitcnt lgkmcnt(0)" ::: "memory");
                }
            }
            unsigned selmask;
            {
                const int cur = qpos >> 6;
                unsigned mask = 1u | (1u << cur) | (cur > 0 ? (1u << (cur - 1)) : 0u);
                const int nforced = __popc(mask); const int tot = cur + 1 < 8 ? cur + 1 : 8; const int need = tot - nforced;
                unsigned cand = (cur >= 31 ? 0xffffffffu : ((2u << cur) - 1u)) & ~mask;
                float v[32];
#pragma unroll
                for (int mm = 0; mm < 32; ++mm) v[mm] = imp[r * 33 + mm];
#pragma unroll
                for (int k = 0; k < 5; ++k) {
                    if (k < need) {
                        float bv = -1.f; int best = 0;
#pragma unroll
                        for (int mm = 0; mm < 32; ++mm) { const bool ok = ((cand >> mm) & 1u) && v[mm] > bv; bv = ok ? v[mm] : bv; best = ok ? mm : best; }
                        mask |= 1u << best; cand &= ~(1u << best);
                    }
                }
                selmask = mask;
            }
#ifndef X_NOP2
            for (int p = 0; p < 4; ++p) {
                const int hd = g * 4 + p;
                lut_write(wl, lutg, 8 + hd, lane);
                bf16x8 qf[4]; q_load<4>(qf, NQ + (size_t)tok * 512 + hd * 64, h);
                const float g0 = GT[(size_t)tok * 24 + hd * 3], g1 = GT[(size_t)tok * 24 + hd * 3 + 1], g2 = GT[(size_t)tok * 24 + hd * 3 + 2];
                LAS float* cb = (LAS float*)(wl + WL_IMP);
                {
                    f32x16 O[2]; o_zero(O); float m = -1e30f, l = 0.f;
                    attn_core<64>(wl, qf, kc, 128, vc, 128, 0, 1, 31, 16, 0, 128, 127, qpos, BIG, 0u, 0, false, true, sc64, O, m, l, lane);
                    l += shx(l, 32); const float f = g0 / fmaxf(l, 1e-30f);
#pragma unroll
                    for (int db = 0; db < 2; ++db)
#pragma unroll
                        for (int i = 0; i < 16; ++i) cb[(32 * db + crow(i, h)) * 32 + r] = O[db][i] * f;
                }
                {
                    f32x16 O[2]; o_zero(O); float m = -1e30f, l = 0.f;
                    attn_core<64>(wl, qf, NKS + g * 64, 128, U + 1312 + g * 64, EVCP, b * S, 1, 0, 1, 0, qs + 32, S, qpos, BIG, selmask, 6, true, true, sc64, O, m, l, lane);
                    l += shx(l, 32); const float f = g1 / fmaxf(l, 1e-30f);
#pragma unroll
                    for (int db = 0; db < 2; ++db)
#pragma unroll
                        for (int i = 0; i < 16; ++i) cb[(32 * db + crow(i, h)) * 32 + r] += O[db][i] * f;
                }
                {
                    f32x16 O[2]; o_zero(O); float m = -1e30f, l = 0.f;
                    int ilo = qs - 511; ilo = ilo < 0 ? 0 : (ilo & ~31);
                    attn_core<64>(wl, qf, NKW + g * 64, 128, U + 1568 + g * 64, EVCP, b * S, 1, 0, 1, ilo, qs + 32, S, qpos, 511, 0u, 0, false, true, sc64, O, m, l, lane);
                    l += shx(l, 32); const float f = g2 / fmaxf(l, 1e-30f);
#pragma unroll
                    for (int db = 0; db < 2; ++db)
#pragma unroll
                        for (int i = 0; i < 16; ++i) O[db][i] = O[db][i] * f + cb[(32 * db + crow(i, h)) * 32 + r];
                    o_store(CAT + (size_t)tok * 1024 + 512 + hd * 64, O, 1.f, h);
                }
            }
#endif
        } else {
            const int jx = it - NNSA, qt = 63 - (jx >> 6), b = (jx >> 3) & 7, hh = jx & 7;
            const int qs = qt * 32, tok = b * S + qs + r, qpos = qs + r;
            bf16x8 qf[6]; q_load<6>(qf, QF + (size_t)tok * 768 + hh * 96, h);
            f32x16 O[2]; o_zero(O); float m = -1e30f, l = 0.f;
#ifndef X_NOMLA
            attn_core<96>(wl, qf, KF + hh * 96, 768, KVFULL + hh * 128 + 64, 1024, b * S, 1, 0, 1, 0, qs + 32, S, qpos, BIG, 0u, 0, false, false, sc96, O, m, l, lane);
#endif
            l += shx(l, 32);
            o_store(CAT + (size_t)tok * 1024 + hh * 64, O, 1.f / fmaxf(l, 1e-30f), h);
        }
    }
}

DI void oattn(const Ctx& C, unsigned* ctr) {
    LAS char* wl = (LAS char*)C.lds + C.wave * WL_BYTES;
    const int lane = C.lane, r = lane & 31, h = lane >> 5;
    const bf16_t* U = (const bf16_t*)(C.ws + WS_U); const bf16_t* NRM = (const bf16_t*)(C.ws + WS_NRM);
    const float* KM = (const float*)(C.ws + WS_KMEAN); const float* lutg = (const float*)(C.ws + WS_LUT);
    bf16_t* CAT = (bf16_t*)(C.ws + WS_CAT);
    const float sc64 = 0.125f * L2E;
    constexpr int NDIL = 2048, NMOBA = 2048, BIG = 1 << 20;
    for (;;) {
        const int it = next_item(ctr, lane);
        if (it >= NDIL + NMOBA) break;
        if (it < NDIL) {
            const int itq = 3 - (it >> 9), b = (it >> 6) & 7, hh = (it >> 4) & 3, rho = it & 15;
            const int qpos = rho + 16 * (32 * itq + r), tok = b * S + qpos;
            f32x16 O[2]; o_zero(O); float m = -1e30f, l = 0.f;
            {
                const int slot = 8 + hh; lut_write(wl, lutg, slot, lane);
                bf16x8 qf[4]; q_load<4>(qf, NRM + (size_t)tok * 2048 + slot * 64, h);
                attn_core<64>(wl, qf, NRM + 768 + slot * 64, 2048, U + 1536 + slot * 64, ODC, b * S + rho, 16, rho, 16, 0, 32 * itq + 32, 128, qpos, BIG, 0u, 0, false, true, sc64, O, m, l, lane);
            }
            {
                const int slot = 4 + hh; lut_write(wl, lutg, slot, lane);
                bf16x8 qf[4]; q_load<4>(qf, NRM + (size_t)tok * 2048 + slot * 64, h);
                const int rho4 = rho & 3; int ilo = 128 * itq - 128; ilo = ilo < 0 ? 0 : ilo;
                attn_core<64>(wl, qf, NRM + 768 + slot * 64, 2048, U + 1536 + slot * 64, ODC, b * S + rho4, 4, rho4, 4, ilo, 128 * itq + 128, 512, qpos, 512, 0u, 0, false, true, sc64, O, m, l, lane);
            }
            {
                const int slot = hh; lut_write(wl, lutg, slot, lane);
                bf16x8 qf[4]; q_load<4>(qf, NRM + (size_t)tok * 2048 + slot * 64, h);
                const int t0 = rho + 512 * itq; int ilo = t0 - 128; ilo = ilo < 0 ? 0 : (ilo & ~31);
                attn_core<64>(wl, qf, NRM + 768 + slot * 64, 2048, U + 1536 + slot * 64, ODC, b * S, 1, 0, 1, ilo, t0 + 497, S, qpos, 128, 0u, 0, false, true, sc64, O, m, l, lane);
            }
            l += shx(l, 32);
            o_store(CAT + (size_t)tok * 512 + hh * 64, O, 1.f / fmaxf(l, 1e-30f), h);
        } else {
            const int jx = it - NDIL, qt = 63 - (jx >> 5), b = (jx >> 2) & 7, hh = jx & 3;
            const int qs = qt * 32, tok = b * S + qs + r, qpos = qs + r, own = qs >> 8;
            lut_write(wl, lutg, 12 + hh, lane);
            const bf16_t* qrow = NRM + (size_t)tok * 2048 + 1536 + hh * 64;
            bf16x8 qf[4]; q_load<4>(qf, qrow, h);
            unsigned mask = 1u << own;
            if (own > 0) {
                float sc[8];
#pragma unroll
                for (int n = 0; n < 8; ++n) sc[n] = 0.f;
                const float* km = KM + (size_t)((b * 4 + hh) * 8) * 64;
                for (int d8 = 0; d8 < 8; ++d8) {
                    const u32x4 w = *(const u32x4*)(qrow + 8 * d8);
                    const float qv[8] = {bflo(w.x), bfhi(w.x), bflo(w.y), bfhi(w.y), bflo(w.z), bfhi(w.z), bflo(w.w), bfhi(w.w)};
#pragma unroll
                    for (int n = 0; n < 8; ++n)
#pragma unroll
                        for (int e = 0; e < 8; ++e) sc[n] += qv[e] * km[n * 64 + 8 * d8 + e];
                }
                const int need = own < 3 ? own : 3; unsigned cand = (1u << own) - 1u;
#pragma unroll
                for (int k = 0; k < 3; ++k) {
                    if (k < need) {
                        float bv = -3e38f; int best = 0;
#pragma unroll
                        for (int n = 0; n < 8; ++n) { const bool ok = ((cand >> n) & 1u) && sc[n] > bv; bv = ok ? sc[n] : bv; best = ok ? n : best; }
                        mask |= 1u << best; cand &= ~(1u << best);
                    }
                }
            }
            f32x16 O[2]; o_zero(O); float m = -1e30f, l = 0.f;
            attn_core<64>(wl, qf, NRM + 1792 + hh * 64, 2048, U + 2816 + hh * 64, ODC, b * S, 1, 0, 1, 0, qs + 32, S, qpos, BIG, mask, 8, true, true, sc64, O, m, l, lane);
            l += shx(l, 32);
            o_store(CAT + (size_t)tok * 512 + 256 + hh * 64, O, 1.f / fmaxf(l, 1e-30f), h);
        }
    }
}

#define XB_TMO      128
#define XB_XCNT(j)  (256  + 64 * (j))
#define XB_XSUB(j)  (1280 + 64 * (j))
#define XB_XGEN(j)  (2304 + 64 * (j))
#define XB_TOP      3328
#define XB_TOPGEN   3392
#define XCD_BAR_WORDS 3456
#define XB_SPIN_CAP (1u << 20)
DI unsigned xb_ld(unsigned* p)              { return __hip_atomic_load(p, __ATOMIC_RELAXED, __HIP_MEMORY_SCOPE_AGENT); }
DI unsigned xb_add(unsigned* p, unsigned v) { return __hip_atomic_fetch_add(p, v, __ATOMIC_RELAXED, __HIP_MEMORY_SCOPE_AGENT); }
DI unsigned xb_xcc_id() { return (unsigned)__builtin_amdgcn_s_getreg((3 << 11) | 20) & 0xFu; }
#define XB_SPIN(cond, bar) do { unsigned _sp = 0; while (cond) { __builtin_amdgcn_s_sleep(1); \
    if ((++_sp & 255u) == 0u) { if (xb_ld(&(bar)[XB_TMO])) break; if (_sp > XB_SPIN_CAP) { atomicAdd(&(bar)[XB_TMO], 1u); break; } } } } while (0)
struct XcdBarrier { unsigned* bar; unsigned x; volatile LAS unsigned* st; };
DI XcdBarrier xcd_barrier_post(unsigned* bar, volatile LAS unsigned* st) {
    XcdBarrier b; b.bar = bar; b.x = xb_xcc_id(); b.st = st;
    if (threadIdx.x == 0) (void)xb_add(&bar[XB_XCNT(b.x)], 1u);
    return b;
}
DI void xcd_barrier_complete(unsigned* bar, unsigned x, unsigned& nloc, unsigned& nx) {
    const unsigned G = gridDim.x * gridDim.y * gridDim.z;
    unsigned sum, cnt, mine, sp = 0u;
    for (;;) {
        sum = 0u; cnt = 0u; mine = 0u;
#pragma unroll
        for (unsigned j = 0; j < 16; ++j) { const unsigned c = xb_ld(&bar[XB_XCNT(j)]); sum += c; cnt += (c > 0u) ? 1u : 0u; mine = (j == x) ? c : mine; }
        if (sum == G) break;
        __builtin_amdgcn_s_sleep(1);
        if ((++sp & 255u) == 0u) { if (xb_ld(&bar[XB_TMO])) break; if (sp > XB_SPIN_CAP) { atomicAdd(&bar[XB_TMO], 1u); break; } }
    }
    nloc = mine > 0u ? mine : 1u; nx = cnt > 0u ? cnt : 1u;
}
DI void xcd_barrier(const XcdBarrier& b) {
    asm volatile("s_waitcnt vmcnt(0)" ::: "memory");
    __syncthreads();
    if (threadIdx.x == 0) {
        unsigned* bar = b.bar;
        __builtin_amdgcn_s_waitcnt(0);
        unsigned nloc = b.st[0], nx = b.st[1];
        if (nloc == 0u) { xcd_barrier_complete(bar, b.x, nloc, nx); b.st[0] = nloc; b.st[1] = nx; }
        const unsigned old = xb_add(&bar[XB_XSUB(b.x)], 1u);
        const unsigned gen = old / nloc;
        if (old + 1u == (gen + 1u) * nloc) {
            __builtin_amdgcn_fence(__ATOMIC_RELEASE, "agent");
            asm volatile("s_waitcnt vmcnt(0)" ::: "memory");
            const unsigned og = xb_add(&bar[XB_TOP], 1u);
            const unsigned tg = og / nx;
            if (og + 1u == (tg + 1u) * nx) xb_add(&bar[XB_TOPGEN], 1u);
            else XB_SPIN(xb_ld(&bar[XB_TOPGEN]) == tg, bar);
            __builtin_amdgcn_fence(__ATOMIC_ACQUIRE, "agent");
            xb_add(&bar[XB_XGEN(b.x)], 1u);
            asm volatile("s_waitcnt vmcnt(0)" ::: "memory");
        } else {
            XB_SPIN(xb_ld(&bar[XB_XGEN(b.x)]) == gen, bar);
            __builtin_amdgcn_fence(__ATOMIC_ACQUIRE, "agent");
            asm volatile("s_waitcnt vmcnt(0)" ::: "memory");
        }
    }
    __syncthreads();
}

enum { K_PRO = 0, K_NORM, K_FFI, K_RESID, K_MIXIN, K_EPOST1, K_EGEMM2, K_EPOST2, K_EATTN, K_OPOST, K_OATTN };
constexpr int NPHASE = 1 + 13 + 11 + 13 + 11;

__global__ void __launch_bounds__(512, 2) fwd_kernel(Args args) {
    extern __shared__ __attribute__((aligned(16))) unsigned char lds_raw[];
    cg::grid_group grid = cg::this_grid();
    Ctx C;
    C.in = args.in; C.out = args.out; C.ws = args.ws; C.lds = (LAS unsigned char*)lds_raw;
    C.tid = threadIdx.x; C.lane = C.tid & 63; C.wave = __builtin_amdgcn_readfirstlane(C.tid >> 6);
    C.G = gridDim.x; C.gw = blockIdx.x * 8 + C.wave; C.NGW = C.G * 8;
    unsigned* ctl = (unsigned*)(C.ws + WS_CTL);
    volatile LAS unsigned* misc = (volatile LAS unsigned*)(C.lds + LDS_MISC);
    if (threadIdx.x < 16) misc[threadIdx.x] = 0u;
    __syncthreads();
    const XcdBarrier xbar = xcd_barrier_post(ctl + CW_BAR, misc);
    const int lo = args.ph_lo, hi = args.ph_hi;
    for (int p = lo; p < hi; ++p) {
        { int t_ = threadIdx.x; asm volatile("" : "+v"(t_)); C.tid = t_; C.lane = t_ & 63; }
        int kind = K_PRO, layer = 0, sub = 0;
        if (p > 0) {
            int q = p - 1;
            if (q < 13) layer = 0; else if (q < 24) { layer = 1; q -= 13; } else if (q < 37) { layer = 2; q -= 24; } else { layer = 3; q -= 37; }
            if (q < 3) { sub = 0; kind = q == 0 ? K_NORM : (q == 1 ? K_FFI : K_RESID); }
            else if ((layer & 1) == 0) {
                if (q >= 10) { sub = 2; const int e = q - 10; kind = e == 0 ? K_NORM : (e == 1 ? K_FFI : K_RESID); }
                else { sub = 1; const int e = q - 3; kind = e == 0 ? K_NORM : e == 1 ? K_MIXIN : e == 2 ? K_EPOST1 : e == 3 ? K_EGEMM2 : e == 4 ? K_EPOST2 : e == 5 ? K_EATTN : K_RESID; }
            } else {
                if (q >= 8) { sub = 2; const int e = q - 8; kind = e == 0 ? K_NORM : (e == 1 ? K_FFI : K_RESID); }
                else { sub = 1; const int e = q - 3; kind = e == 0 ? K_NORM : e == 1 ? K_MIXIN : e == 2 ? K_OPOST : e == 3 ? K_OATTN : K_RESID; }
            }
        }
        const int j = layer >> 1; const bool even = (layer & 1) == 0;
        const float* xcur = (layer == 0 && sub == 0) ? C.in[0] : C.out;
#ifndef DIS_PRO
        if (kind == K_PRO) prologue(C);
#else
        if (0) {}
#endif
        else if (kind == K_NORM) norm_phase(C, xcur, layer, sub);
        else if (kind == K_FFI) {
            pg8::Gemm g{(const bf16_t*)(C.ws + WS_Y), (const bf16_t*)(C.ws + WS_WFI) + (size_t)(layer * 2 + (sub >> 1)) * NFF * D, M, NFF, D};
            pg8::StaticOrder So; So.init(M, NFF, C.G, (int)blockIdx.x);
            pg8::EpiSwiglu E{(bf16_t*)(C.ws + WS_H), DFFP};
#ifndef DIS_G1
            pg8::gemm_phase<pg8::EpiSwiglu, pg8::StaticOrder, true>(C.lds, g, So, E);
#endif
        } else if (kind == K_RESID) {
            pg8::Gemm g; float gmul;
            if (sub != 1) { g = pg8::Gemm{(const bf16_t*)(C.ws + WS_H), (const bf16_t*)(C.ws + WS_WFO) + (size_t)(layer * 2 + (sub >> 1)) * D * DFFP, M, D, DFFP}; gmul = 0.5f; }
            else if (even) { g = pg8::Gemm{(const bf16_t*)(C.ws + WS_CAT), (const bf16_t*)(C.ws + WS_WEO) + (size_t)j * D * D, M, D, D}; gmul = 1.f; }
            else { g = pg8::Gemm{(const bf16_t*)(C.ws + WS_CAT), (const bf16_t*)(C.ws + WS_WOO) + (size_t)j * D * 512, M, D, 512}; gmul = 1.f; }
            pg8::StaticOrder So; So.init(M, D, C.G, (int)blockIdx.x);
            pg8::EpiResid E{xcur, C.out, (const float*)(C.ws + WS_MOD) + (size_t)layer * 8 * 9216 + sub * 3072 + 2048, gmul};
#ifndef DIS_G2
            pg8::gemm_phase<pg8::EpiResid, pg8::StaticOrder, false>(C.lds, g, So, E);
#endif
        } else if (kind == K_MIXIN || kind == K_EGEMM2) {
            const int g_lo = kind == K_MIXIN ? 0 : 1, g_hi = kind == K_MIXIN ? 1 : 5;
            for (int gi = g_lo; gi < g_hi; ++gi) {
                pg8::Gemm g; pg8::EpiBf16 E; int shift = 0;
                if (gi == 0) {
                    if (even) { g = pg8::Gemm{(const bf16_t*)(C.ws + WS_Y), (const bf16_t*)(C.ws + WS_WEI) + (size_t)j * EVCP * D, M, EVCP, D}; E = pg8::EpiBf16{(bf16_t*)(C.ws + WS_U), EVCP, 0}; }
                    else { g = pg8::Gemm{(const bf16_t*)(C.ws + WS_Y), (const bf16_t*)(C.ws + WS_WOI) + (size_t)j * ODC * D, M, ODC, D}; E = pg8::EpiBf16{(bf16_t*)(C.ws + WS_U), ODC, 0}; }
                } else if (gi <= 2) {
                    const int kd = gi - 1;
                    g = pg8::Gemm{(const bf16_t*)(C.ws + WS_ACMP) + (size_t)kd * 2048 * 2048, (const bf16_t*)(C.ws + WS_WC1) + (size_t)(j * 2 + kd) * 256 * 2048, 2048, 256, 2048};
                    E = pg8::EpiBf16{(bf16_t*)(C.ws + WS_HID) + (size_t)kd * 2048 * 256, 256, 1}; shift = kd * 8;
                } else if (gi == 3) {
                    g = pg8::Gemm{(const bf16_t*)(C.ws + WS_CQN), (const bf16_t*)(C.ws + WS_WUQ) + (size_t)j * 768 * 256, M, 768, 256};
                    E = pg8::EpiBf16{(bf16_t*)(C.ws + WS_QFULL), 768, 0}; shift = 16;
                } else {
                    g = pg8::Gemm{(const bf16_t*)(C.ws + WS_CKVN), (const bf16_t*)(C.ws + WS_WUKV) + (size_t)j * 1024 * 128, M, 1024, 128};
                    E = pg8::EpiBf16{(bf16_t*)(C.ws + WS_KVFULL), 1024, 0}; shift = 208;
                }
                pg8::StaticOrder So; So.init(g.M, g.N, C.G, ((int)blockIdx.x - shift % C.G + C.G) % C.G);
#ifndef DIS_G3
                pg8::gemm_phase<pg8::EpiBf16, pg8::StaticOrder, true>(C.lds, g, So, E);
#endif
            }
        }
#ifndef DIS_EP1
        else if (kind == K_EPOST1) epost1(C, j);
#endif
#ifndef DIS_EP2
        else if (kind == K_EPOST2) epost2(C, j);
#endif
#ifndef DIS_EATTN
        else if (kind == K_EATTN) eattn(C, ctl + 64 * p);
#endif
#ifndef DIS_OPOST
        else if (kind == K_OPOST) opost(C, j);
#endif
#ifndef DIS_OATTN
        else if (kind == K_OATTN) oattn(C, ctl + 64 * p);
#endif
        if (p + 1 < hi) { if (p == 0) grid.sync(); else xcd_barrier(xbar); }
    }
}

extern "C" void kernel_launch(void* const* d_in, const int* in_sizes, int n_in, void* d_out, int out_size, void* d_ws, size_t ws_size, hipStream_t stream) {
    static int grid = 0;
    if (grid == 0) {
        if (n_in != 23 || out_size != M * D || ws_size < WS_END) { fprintf(stderr, "kernel_launch: unexpected sizes n_in %d out %d ws %zu\n", n_in, out_size, ws_size); grid = -1; return; }
        int dev = 0, cus = 0, per_cu = 0;
        hipGetDevice(&dev); hipDeviceGetAttribute(&cus, hipDeviceAttributeMultiprocessorCount, dev);
        hipFuncSetAttribute((const void*)fwd_kernel, hipFuncAttributeMaxDynamicSharedMemorySize, LDS_BYTES);
        hipOccupancyMaxActiveBlocksPerMultiprocessor(&per_cu, (const void*)fwd_kernel, 512, LDS_BYTES);
        (void)hipGetLastError();
        if (per_cu < 1) per_cu = 1;
        grid = cus * 1;
        fprintf(stderr, "kernel_launch: cus %d per_cu %d grid %d\n", cus, per_cu, grid);
    }
    if (grid < 0) return;
    hipMemsetAsync((char*)d_ws + WS_CTL, 0, CTL_BYTES, stream);
    Args a{};
    for (int i = 0; i < 23; ++i) a.in[i] = (const float*)d_in[i];
    a.out = (float*)d_out; a.ws = (unsigned char*)d_ws; a.ph_lo = 0; a.ph_hi = NPHASE;
    void* kargs[] = {&a};
    hipError_t e = hipLaunchCooperativeKernel((const void*)fwd_kernel, dim3(grid), dim3(512), kargs, LDS_BYTES, stream);
    if (e != hipSuccess) fprintf(stderr, "cooperative launch failed: %s (grid %d)\n", hipGetErrorString(e), grid);
}
```
